# Optimizing an MI355X kernel written in HIP

```python
import jax, jax.numpy as jnp
from jax import lax
import numpy as np

D_MODEL = 2048
BATCH = 2
SEQ = 16384
DEPTH = 1

GRID_W = 64
CTX_LEN = 256

GLA_HEADS = 4
GLA_DK = 128
GLA_DV = 256
GLA_KEY_WIDTH = GLA_HEADS * GLA_DK
GLA_WIDTH = GLA_HEADS * GLA_DV
GLA_GATE_RANK = 16
GLA_GATE_TAU = 16.0
GLA_CHUNK = 64

CMLP_GROUPS = 8
CMLP_GROUP_DIM = 128
CMLP_WIDTH = CMLP_GROUPS * CMLP_GROUP_DIM
CMLP_CHUNK = 128
ROWS_PER_CHUNK = CMLP_CHUNK // GRID_W

MIX_WIDTH = GLA_WIDTH + CMLP_WIDTH

IN_SIZES = (GLA_KEY_WIDTH, GLA_KEY_WIDTH, GLA_WIDTH, GLA_WIDTH, 2 * GLA_GATE_RANK, CMLP_WIDTH, CMLP_WIDTH)
IN_WIDTH = sum(IN_SIZES)
IN_OFFSETS = tuple(int(o) for o in np.cumsum(IN_SIZES)[:-1])

PEER_HEADS = 8
PEER_NKEYS = 128
PEER_EXPERTS = PEER_NKEYS * PEER_NKEYS
PEER_QDIM = 256
PEER_HALF = PEER_QDIM // 2
PEER_TOPK = 16
PEER_BLOCK = 128

N_MOD = 6
EPS = 1e-6

kernel_name = "hybrid_gla_chunkmlp_peer_dit_block"


def rmsnorm(x, g):
    xf = x.astype(jnp.float32)
    y = xf * lax.rsqrt(jnp.mean(xf * xf, axis=-1, keepdims=True) + EPS)
    return (y * g.astype(jnp.float32)).astype(x.dtype)


def modulate(x, shift, scale):
    return x * (1.0 + scale) + shift


def gla_scan(q, k, v, log_a, s0):
    b, l, h, _ = q.shape
    n = l // GLA_CHUNK

    def to_chunks(t):
        return t.astype(jnp.float32).reshape(b, n, GLA_CHUNK, h, t.shape[-1]).transpose(1, 0, 3, 2, 4)

    prefix_mask = jnp.tril(jnp.ones((GLA_CHUNK, GLA_CHUNK), dtype=bool))

    def step(state, inp):
        qc, kc, vc, ac = inp
        cum = jnp.cumsum(ac, axis=2)
        tot = cum[:, :, -1:, :]
        q_dec = qc * jnp.exp(cum)
        scores = jnp.einsum('bhid,bhjd->bhij', q_dec, kc * jnp.exp(-cum))
        scores = jnp.where(prefix_mask, scores, 0.0)
        out = (jnp.einsum('bhij,bhje->bhie', scores, vc)
               + jnp.einsum('bhid,bhde->bhie', q_dec, state))
        k_dec = kc * jnp.exp(tot - cum)
        state = (jnp.exp(tot[:, :, 0, :])[..., None] * state
                 + jnp.einsum('bhjd,bhje->bhde', k_dec, vc))
        return state, out

    state, out = lax.scan(step, s0, (to_chunks(q), to_chunks(k), to_chunks(v), to_chunks(log_a)))
    out = out.transpose(1, 0, 3, 2, 4).reshape(b, l, h, v.shape[-1])
    return out, state


def gla_heads(parts, w_gate_up, b_gate):
    q, k, v, g, lr = parts
    b, l, _ = q.shape
    q = q.reshape(b, l, GLA_HEADS, GLA_DK) * (GLA_DK ** -0.5)
    k = k.reshape(b, l, GLA_HEADS, GLA_DK)
    v = v.reshape(b, l, GLA_HEADS, GLA_DV)

    def log_decay(d):
        z = lr[..., d * GLA_GATE_RANK:(d + 1) * GLA_GATE_RANK] @ w_gate_up[d] + b_gate[d]
        return (jax.nn.log_sigmoid(z.astype(jnp.float32)) / GLA_GATE_TAU).reshape(b, l, GLA_HEADS, GLA_DK)

    return q, k, v, log_decay(0), log_decay(1), g


def gla_out(o, g, norm_g):
    b, l = o.shape[:2]
    o = o * lax.rsqrt(jnp.mean(o * o, axis=-1, keepdims=True) + EPS)
    o = o.reshape(b, l, GLA_WIDTH) * norm_g.astype(jnp.float32)
    return (o * jax.nn.silu(g.astype(jnp.float32))).astype(g.dtype)


def gla_mixer(lat_parts, ctx_parts, w_gate_up, b_gate, norm_g, need_ctx):
    ql, kl, vl, afl, abl, gl = gla_heads(lat_parts, w_gate_up, b_gate)
    qc, kc, vc, afc, abc, gc = gla_heads(ctx_parts, w_gate_up, b_gate)
    flip = lambda t: t[:, ::-1]
    s0 = jnp.zeros((qc.shape[0], GLA_HEADS, GLA_DK, GLA_DV), jnp.float32)
    o_cf, s_f = gla_scan(qc, kc, vc, afc, s0)
    o_cb, s_b = gla_scan(flip(qc), flip(kc), flip(vc), flip(abc), s0)
    o_lf, _ = gla_scan(ql, kl, vl, afl, s_f)
    o_lb, _ = gla_scan(flip(ql), flip(kl), flip(vl), flip(abl), s_b)
    y_lat = gla_out(o_lf + flip(o_lb), gl, norm_g)
    y_ctx = gla_out(o_cf + flip(o_cb), gc, norm_g) if need_ctx else None
    return y_lat, y_ctx


def chunk_mlp(u, v, ln_g, ln_b, w_s, b_s, n_chunks):
    b, l, _ = u.shape
    u = jax.nn.gelu(u, approximate=False)
    vf = jax.nn.gelu(v.astype(jnp.float32), approximate=False)
    mu = jnp.mean(vf, axis=-1, keepdims=True)
    var = jnp.mean(jnp.square(vf - mu), axis=-1, keepdims=True)
    vn = ((vf - mu) * lax.rsqrt(var + EPS) * ln_g.astype(jnp.float32) + ln_b.astype(jnp.float32)).astype(u.dtype)
    vn = vn.reshape(b, n_chunks, CMLP_CHUNK, CMLP_GROUPS, CMLP_GROUP_DIM)
    s = jnp.einsum('gpq,bnqgc->bnpgc', w_s, vn) + b_s.T[:, :, None]
    return u * s.reshape(b, l, CMLP_WIDTH)


def peer_ffn(xn, w_q, sub_keys, exp_u, exp_v):
    b, l, d = xn.shape
    blocks = xn.reshape(-1, PEER_BLOCK, d)

    def block(xb):
        p = xb.shape[0]
        q = (xb @ w_q).reshape(p, PEER_HEADS, 2, PEER_HALF)
        s1 = jnp.einsum('phd,hkd->phk', q[:, :, 0], sub_keys[0])
        s2 = jnp.einsum('phd,hkd->phk', q[:, :, 1], sub_keys[1])
        v1, i1 = lax.top_k(s1, PEER_TOPK)
        v2, i2 = lax.top_k(s2, PEER_TOPK)
        cand = (v1[..., :, None] + v2[..., None, :]).reshape(p, PEER_HEADS, PEER_TOPK * PEER_TOPK)
        cidx = (i1[..., :, None] * PEER_NKEYS + i2[..., None, :]).reshape(p, PEER_HEADS, PEER_TOPK * PEER_TOPK)
        best, pos = lax.top_k(cand, PEER_TOPK)
        eidx = jnp.take_along_axis(cidx, pos, axis=-1)
        gate = jax.nn.softmax(best.astype(jnp.float32), axis=-1).astype(xb.dtype)
        u = exp_u[eidx]
        act = jax.nn.gelu(jnp.einsum('pd,phkd->phk', xb, u), approximate=False)
        return jnp.einsum('phk,phkd->pd', gate * act, exp_v[eidx])

    return lax.map(block, blocks).reshape(b, l, d)


def setup_inputs(seed: int = 0) -> dict:
    key = jax.random.key(seed)
    ks = jax.random.split(key, 24)
    f32 = jnp.float32
    nrm = lambda k, shape, s: jax.random.normal(k, shape, f32) * s
    D = D_MODEL
    return {
        "x": nrm(ks[0], (BATCH, SEQ, D), 1.0),
        "c": nrm(ks[1], (BATCH, D), 1.0),
        "ctx": nrm(ks[2], (BATCH, CTX_LEN, D), 1.0),
        "c_ctx": nrm(ks[3], (D,), 1.0),
        "norm1_g": 1.0 + nrm(ks[4], (DEPTH, D), 0.02),
        "norm2_g": 1.0 + nrm(ks[5], (DEPTH, D), 0.02),
        "w_mod": nrm(ks[6], (DEPTH, D, N_MOD * D), D ** -0.5),
        "b_mod": nrm(ks[7], (DEPTH, N_MOD * D), 0.02),
        "w_in": nrm(ks[8], (DEPTH, D, IN_WIDTH), D ** -0.5),
        "w_gate_up": nrm(ks[9], (DEPTH, 2, GLA_GATE_RANK, GLA_KEY_WIDTH), GLA_GATE_RANK ** -0.5),
        "b_gate": nrm(ks[10], (DEPTH, 2, GLA_KEY_WIDTH), 0.1),
        "gla_norm_g": 1.0 + nrm(ks[11], (DEPTH, GLA_WIDTH), 0.02),
        "cmlp_ln_g": 1.0 + nrm(ks[12], (DEPTH, CMLP_WIDTH), 0.02),
        "cmlp_ln_b": nrm(ks[13], (DEPTH, CMLP_WIDTH), 0.02),
        "w_spatial": nrm(ks[14], (DEPTH, CMLP_GROUPS, CMLP_CHUNK, CMLP_CHUNK), CMLP_CHUNK ** -0.5),
        "b_spatial": nrm(ks[15], (DEPTH, CMLP_GROUPS, CMLP_CHUNK), 0.02),
        "w_out": nrm(ks[16], (DEPTH, MIX_WIDTH, D), MIX_WIDTH ** -0.5),
        "peer_wq": nrm(ks[17], (DEPTH, D, PEER_HEADS * PEER_QDIM), D ** -0.5),
        "peer_sub_keys": nrm(ks[18], (DEPTH, 2, PEER_HEADS, PEER_NKEYS, PEER_HALF), PEER_HALF ** -0.5),
        "peer_u": nrm(ks[19], (DEPTH, PEER_EXPERTS, D), D ** -0.5),
        "peer_v": nrm(ks[20], (DEPTH, PEER_EXPERTS, D), PEER_HEADS ** -0.5),
        "final_norm_g": 1.0 + nrm(ks[21], (D,), 0.02),
    }


def reference(x, c, ctx, c_ctx, norm1_g, norm2_g, w_mod, b_mod, w_in, w_gate_up, b_gate,
              gla_norm_g, cmlp_ln_g, cmlp_ln_b, w_spatial, b_spatial, w_out,
              peer_wq, peer_sub_keys, peer_u, peer_v, final_norm_g):
    rows = x.shape[1] // GRID_W
    lat_chunks = rows // ROWS_PER_CHUNK
    ctx_chunks = ctx.shape[1] // CMLP_CHUNK
    silu_c = jax.nn.silu(c)
    silu_cc = jax.nn.silu(c_ctx)
    h, hc = x, ctx
    for i in range(DEPTH):
        need_ctx = i + 1 < DEPTH
        m = silu_c @ w_mod[i] + b_mod[i]
        mc = silu_cc @ w_mod[i] + b_mod[i]
        sh1, sc1, g1, sh2, sc2, g2 = jnp.split(m[:, None, :], N_MOD, axis=-1)
        csh1, csc1, cg1, csh2, csc2, cg2 = jnp.split(mc, N_MOD, axis=-1)

        p_lat = jnp.split(modulate(rmsnorm(h, norm1_g[i]), sh1, sc1) @ w_in[i], IN_OFFSETS, axis=-1)
        p_ctx = jnp.split(modulate(rmsnorm(hc, norm1_g[i]), csh1, csc1) @ w_in[i], IN_OFFSETS, axis=-1)
        gla_lat, gla_ctx = gla_mixer(p_lat[:5], p_ctx[:5], w_gate_up[i], b_gate[i], gla_norm_g[i], need_ctx)
        cm_lat = chunk_mlp(p_lat[5], p_lat[6], cmlp_ln_g[i], cmlp_ln_b[i], w_spatial[i], b_spatial[i], lat_chunks)
        h = h + g1 * (jnp.concatenate([gla_lat, cm_lat], axis=-1) @ w_out[i])

        h = h + g2 * peer_ffn(modulate(rmsnorm(h, norm2_g[i]), sh2, sc2),
                              peer_wq[i], peer_sub_keys[i], peer_u[i], peer_v[i])

        if need_ctx:
            cm_ctx = chunk_mlp(p_ctx[5], p_ctx[6], cmlp_ln_g[i], cmlp_ln_b[i], w_spatial[i], b_spatial[i], ctx_chunks)
            hc = hc + cg1 * (jnp.concatenate([gla_ctx, cm_ctx], axis=-1) @ w_out[i])
            hc = hc + cg2 * peer_ffn(modulate(rmsnorm(hc, norm2_g[i]), csh2, csc2),
                                     peer_wq[i], peer_sub_keys[i], peer_u[i], peer_v[i])
    return rmsnorm(h, final_norm_g)
```

```cpp
#include <hip/hip_runtime.h>
#include <hip/hip_cooperative_groups.h>
#include <cstdio>
#include <cstdint>
#define N_LAUNCH_MODE 1
#define PEER_NHI_SET 0
namespace pg8 {
#define PG8_LAS __attribute__((address_space(3)))
typedef unsigned short bf16_t;
typedef short bf16x8 __attribute__((ext_vector_type(8)));
typedef float f32x4 __attribute__((ext_vector_type(4)));
typedef unsigned u32x4 __attribute__((ext_vector_type(4)));
constexpr int BM = 256, BK = 64, HALF = 128, HTB = HALF * BK * 2  , STAGE_BYTES = 8 * HTB, NXCD = 8, WGM = 8;

__host__ __device__ __forceinline__ int lds_byte(int r, int c) { const int st = (r >> 4) * 2 + (c >> 5), rr = r & 15, cc = c & 31, ob = rr * 64 + cc * 2; return st * 1024 + (ob ^ (((ob >> 9) & 1) << 5)); }
__host__ __device__ __forceinline__ void stage_rc(int b, int& R, int& C) { const int st = b / 1024, sb = b % 1024, swz = sb ^ (((sb >> 9) & 1) << 5); R = (st >> 1) * 16 + swz / 64; C = (st & 1) * 32 + (swz % 64) / 2; }
__host__ __device__ __forceinline__ int perm32(int rho) { const int n = rho >> 4, i = rho & 15; return 8 * (i >> 2) + 4 * n + (i & 3); }

struct Unit { int pm, pn; };
struct Gemm { const bf16_t* A; const bf16_t* Bt; int M, N, K; };

struct StaticOrder {
    int nM, nN, nwg, G, c;
    __host__ __device__ void init(int M, int N, int G_, int c_) { nM = M / BM; nN = N / BM; nwg = nM * nN; G = G_; c = c_; }
    __host__ __device__ bool next(int i, Unit& u) const {
        const long L = (long)i * G + c; if (L >= nwg) return false;
        int wgid = (int)L; { const int q = nwg / NXCD, r = nwg % NXCD, xcd = wgid % NXCD, off = wgid / NXCD; wgid = (xcd < r ? xcd * (q + 1) : r * (q + 1) + (xcd - r) * q) + off; }
        const int nig = WGM * nN, gid = wgid / nig, fm = gid * WGM, gsz = (nM - fm) < WGM ? (nM - fm) : WGM;
        u.pm = fm + ((wgid % nig) % gsz); u.pn = (wgid % nig) / gsz; return true;
    }
    __device__ __forceinline__ void a_ready(const Unit&) const {}
    __device__ __forceinline__ void done(const Unit&) const {}
};
__device__ __forceinline__ unsigned cvt_pk_bf16(float lo, float hi) { unsigned r; asm volatile("v_cvt_pk_bf16_f32 %0, %1, %2" : "=v"(r) : "v"(lo), "v"(hi)); return r; }
typedef float f32x2 __attribute__((ext_vector_type(2)));
__device__ __forceinline__ f32x2 gelu_pk(f32x2 v) {
    const f32x2 av = __builtin_elementwise_abs(v), d = av * 0.2316418882f + 1.0f;
    f32x2 t; t.x = __builtin_amdgcn_rcpf(d.x); t.y = __builtin_amdgcn_rcpf(d.y);
    f32x2 q = t * 0.5307027145f + (-0.7265760135f); q = q * t + 0.7107068705f; q = q * t + (-0.142248368f); q = q * t + 0.127414796f; q = q * t;
    const f32x2 s = (v * v) * (-0.72134752044f);
    f32x2 e; e.x = __builtin_amdgcn_exp2f(s.x); e.y = __builtin_amdgcn_exp2f(s.y);
    const f32x2 m = v * (q * e), r = v - m;
    f32x2 o; o.x = v.x < 0.f ? m.x : r.x; o.y = v.y < 0.f ? m.y : r.y; return o;
}

struct EpiF32 {
    static constexpr bool PERM = false, AFTER_DRAIN = false;
    float* C; int ldc; const float* bias;
    __device__ __forceinline__ void operator()(const f32x4 (&acc)[2][2][4][2], const Unit& u, int wr, int wc, int fr, int fq) const {
        const int row0 = u.pm * BM + wr * 64 + fr, col0 = u.pn * BM + wc * 32 + 4 * fq;
        f32x4 bv[2][2];
#pragma unroll
        for (int bj = 0; bj < 2; ++bj)
#pragma unroll
            for (int n = 0; n < 2; ++n) bv[bj][n] = bias ? *(const f32x4*)(bias + col0 + bj * HALF + n * 16) : (f32x4){0.f, 0.f, 0.f, 0.f};
#pragma unroll
        for (int ai = 0; ai < 2; ++ai)
#pragma unroll
            for (int m = 0; m < 4; ++m) { float* rowp = C + (size_t)(row0 + ai * HALF + m * 16) * ldc + col0;
#pragma unroll
                for (int bj = 0; bj < 2; ++bj)
#pragma unroll
                    for (int n = 0; n < 2; ++n) *(f32x4*)(rowp + bj * HALF + n * 16) = acc[ai][bj][m][n] + bv[bj][n]; }
    }
};
template <class Epi, class Sched, bool ALIGN_EPI = false, bool SP2 = false>
__device__ __forceinline__ void gemm_phase(PG8_LAS unsigned char* lds, const Gemm g, const Sched& S, const Epi& E) {
    int tid_ = threadIdx.x; asm volatile("" : "+v"(tid_));
    const int tid = tid_, wid = __builtin_amdgcn_readfirstlane(tid >> 6), lane = tid & 63, wr = wid >> 2, wc = wid & 3, fr = lane & 15, fq = lane >> 4;
    const int K = g.K, nt = K / BK;
    unsigned voffA[2], voffB[2];
#pragma unroll
    for (int i = 0; i < 2; ++i) { int R, C; stage_rc(tid * 16 + i * 8192, R, C); const int Rb = Epi::PERM ? ((R & ~31) + perm32(R & 31)) : R;
        voffA[i] = (unsigned)(R * K + C) * 2u; voffB[i] = (unsigned)(Rb * K + C) * 2u; }
    const size_t kstep = (size_t)(BK * 2);
    const size_t hstep = (size_t)HALF * K * 2;
    const size_t tstep = 2 * hstep;
    const unsigned ldsw = (unsigned)wid * 1024u;
    const int aoff = lds_byte(wr * 64 + fr, fq * 8), boff = lds_byte(wc * 32 + fr, fq * 8);
#define PG8_SA(b, h) (((b) * 2 + (h)) * HTB)
#define PG8_SB(b, h) ((4 + (b) * 2 + (h)) * HTB)
#define PG8_STAGE(bufoff, gbase, voff) do { _Pragma("unroll") for (int _i = 0; _i < 2; ++_i) \
        __builtin_amdgcn_global_load_lds((const unsigned*)((const char*)(gbase) + (voff)[_i]), (PG8_LAS unsigned*)(lds + (bufoff) + ldsw + _i * 8192), 16, 0, 0); } while (0)
#define PG8_LDA(dst, b, h) do { _Pragma("unroll") for (int m = 0; m < 4; ++m) _Pragma("unroll") for (int k = 0; k < 2; ++k) dst[m][k] = *(const PG8_LAS bf16x8*)(lds + PG8_SA(b, h) + aoff + m * 2048 + k * 1024); } while (0)
#define PG8_LDB(dst, b, h) do { _Pragma("unroll") for (int n = 0; n < 2; ++n) _Pragma("unroll") for (int k = 0; k < 2; ++k) dst[n][k] = *(const PG8_LAS bf16x8*)(lds + PG8_SB(b, h) + boff + n * 2048 + k * 1024); } while (0)
#define PG8_MMA(ai, bj, At, Bt) do { __builtin_amdgcn_s_setprio(1); _Pragma("unroll") for (int m = 0; m < 4; ++m) _Pragma("unroll") for (int n = 0; n < 2; ++n) _Pragma("unroll") for (int k = 0; k < 2; ++k) \
        acc[ai][bj][m][n] = __builtin_amdgcn_mfma_f32_16x16x32_bf16(Bt[n][k], At[m][k], acc[ai][bj][m][n], 0, 0, 0); __builtin_amdgcn_s_setprio(0); } while (0)
#define PG8_WAIT_V(n) asm volatile("s_waitcnt vmcnt(" #n ")" ::: "memory")
#define PG8_WAIT_L(n) asm volatile("s_waitcnt lgkmcnt(" #n ")" ::: "memory")
#define PG8_BAR __builtin_amdgcn_s_barrier()
#define PG8_SCHED __builtin_amdgcn_sched_barrier(0)
    Unit cur, nxt; int ui = 0;
    if (!S.next(0, cur)) return;
    f32x4 acc[2][2][4][2];
#pragma unroll
    for (int a = 0; a < 2; ++a)
#pragma unroll
        for (int b = 0; b < 2; ++b)
#pragma unroll
            for (int m = 0; m < 4; ++m)
#pragma unroll
                for (int n = 0; n < 2; ++n) acc[a][b][m][n] = (f32x4){0.f, 0.f, 0.f, 0.f};
    bf16x8 At[4][2], B0[2][2], B1[2][2];
    const char* cA = (const char*)g.A + (size_t)cur.pm * tstep; const char* cB = (const char*)g.Bt + (size_t)E.btile(cur) * tstep;
    S.a_ready(cur);
    if constexpr (SP2) {
        PG8_STAGE(PG8_SB(0, 0), cB, voffB); PG8_STAGE(PG8_SB(0, 1), cB + hstep, voffB); PG8_STAGE(PG8_SA(0, 0), cA, voffA); PG8_STAGE(PG8_SA(0, 1), cA + hstep, voffA);
        if (wr == 1) PG8_BAR;
        PG8_WAIT_V(2); PG8_BAR;
        PG8_STAGE(PG8_SB(1, 0), cB + kstep, voffB); PG8_STAGE(PG8_SA(1, 0), cA + kstep, voffA); PG8_STAGE(PG8_SB(1, 1), cB + hstep + kstep, voffB);
        PG8_WAIT_V(6); PG8_BAR;
    } else {
        PG8_STAGE(PG8_SB(0, 0), cB, voffB); PG8_STAGE(PG8_SA(0, 0), cA, voffA); PG8_STAGE(PG8_SB(0, 1), cB + hstep, voffB); PG8_STAGE(PG8_SA(0, 1), cA + hstep, voffA);
        if (wr == 1) PG8_BAR;
        PG8_WAIT_V(4); PG8_BAR;
        PG8_STAGE(PG8_SB(1, 0), cB + kstep, voffB); PG8_STAGE(PG8_SA(1, 0), cA + kstep, voffA); PG8_STAGE(PG8_SB(1, 1), cB + hstep + kstep, voffB);
        PG8_WAIT_V(6); PG8_BAR;
    }
    for (;;) {
        const bool has_next = S.next(ui + 1, nxt);
        const char* nA = has_next ? (const char*)g.A + (size_t)nxt.pm * tstep : cA; const char* nB = has_next ? (const char*)g.Bt + (size_t)E.btile(nxt) * tstep : cB;
        for (int t = 0; t < nt; t += 2) {
            const bool last = (t == nt - 2);
            const char* a1 = cA + (size_t)(t + 1) * kstep;
            const char* a2 = last ? nA : cA + (size_t)(t + 2) * kstep; const char* b2 = last ? nB : cB + (size_t)(t + 2) * kstep;
            const char* a3 = a2 + kstep; const char* b3 = b2 + kstep;
            if (last && has_next) S.a_ready(nxt);
            if constexpr (SP2) {
            PG8_LDB(B0, 0, 0); PG8_LDB(B1, 0, 1); PG8_SCHED; PG8_LDA(At, 0, 0); PG8_STAGE(PG8_SA(1, 1), a1 + hstep, voffA);
            PG8_WAIT_V(8); PG8_WAIT_L(0); PG8_BAR; PG8_MMA(0, 0, At, B0); PG8_MMA(0, 1, At, B1); PG8_BAR; PG8_SCHED;
            PG8_LDA(At, 0, 1); PG8_STAGE(PG8_SB(0, 0), b2, voffB); PG8_STAGE(PG8_SB(0, 1), b2 + hstep, voffB); PG8_STAGE(PG8_SA(0, 0), a2, voffA);
            PG8_WAIT_V(8); PG8_WAIT_L(0); PG8_BAR; PG8_MMA(1, 0, At, B0); PG8_MMA(1, 1, At, B1); PG8_BAR; PG8_SCHED;
            PG8_LDB(B0, 1, 0); PG8_LDB(B1, 1, 1); PG8_SCHED; PG8_LDA(At, 1, 0); PG8_STAGE(PG8_SA(0, 1), a2 + hstep, voffA);
            PG8_WAIT_V(8); PG8_WAIT_L(0); PG8_BAR; PG8_MMA(0, 0, At, B0); PG8_MMA(0, 1, At, B1); PG8_BAR; PG8_SCHED;
            PG8_LDA(At, 1, 1); PG8_STAGE(PG8_SB(1, 0), b3, voffB); PG8_STAGE(PG8_SB(1, 1), b3 + hstep, voffB); PG8_STAGE(PG8_SA(1, 0), a3, voffA);
            PG8_WAIT_V(8); PG8_WAIT_L(0); PG8_BAR; PG8_MMA(1, 0, At, B0); PG8_MMA(1, 1, At, B1); PG8_BAR; PG8_SCHED;
            } else {
            PG8_LDB(B0, 0, 0); PG8_SCHED; PG8_LDA(At, 0, 0); PG8_STAGE(PG8_SA(1, 1), a1 + hstep, voffA);
            PG8_WAIT_L(8); PG8_BAR; PG8_WAIT_L(0); PG8_MMA(0, 0, At, B0); PG8_BAR; PG8_SCHED;
            PG8_LDB(B1, 0, 1); PG8_STAGE(PG8_SB(0, 0), b2, voffB);
            PG8_BAR; PG8_WAIT_L(0); PG8_MMA(0, 1, At, B1); PG8_BAR;
            PG8_LDA(At, 0, 1); PG8_STAGE(PG8_SA(0, 0), a2, voffA);
            PG8_BAR; PG8_WAIT_L(0); PG8_MMA(1, 0, At, B0); PG8_BAR; PG8_SCHED;
            PG8_STAGE(PG8_SB(0, 1), b2 + hstep, voffB);
            PG8_WAIT_V(6); PG8_BAR; PG8_MMA(1, 1, At, B1); PG8_BAR;
            PG8_LDB(B0, 1, 0); PG8_SCHED; PG8_LDA(At, 1, 0); PG8_STAGE(PG8_SA(0, 1), a2 + hstep, voffA);
            PG8_WAIT_L(8); PG8_BAR; PG8_WAIT_L(0); PG8_MMA(0, 0, At, B0); PG8_BAR; PG8_SCHED;
            PG8_LDB(B1, 1, 1); PG8_STAGE(PG8_SB(1, 0), b3, voffB);
            PG8_BAR; PG8_WAIT_L(0); PG8_MMA(0, 1, At, B1); PG8_BAR;
            PG8_LDA(At, 1, 1); PG8_STAGE(PG8_SA(1, 0), a3, voffA);
            PG8_BAR; PG8_WAIT_L(0); PG8_MMA(1, 0, At, B0); PG8_BAR; PG8_SCHED;
            PG8_STAGE(PG8_SB(1, 1), b3 + hstep, voffB);
            PG8_WAIT_V(6); PG8_BAR; PG8_MMA(1, 1, At, B1); PG8_BAR;
            }
        }
        if constexpr (ALIGN_EPI) { if (wr == 0) PG8_BAR; }
        if constexpr (!Epi::AFTER_DRAIN) { E(acc, cur, wr, wc, fr, fq); S.done(cur); }
        if (!has_next) break;
#pragma unroll
        for (int a = 0; a < 2; ++a)
#pragma unroll
            for (int b = 0; b < 2; ++b)
#pragma unroll
                for (int m = 0; m < 4; ++m)
#pragma unroll
                    for (int n = 0; n < 2; ++n) acc[a][b][m][n] = (f32x4){0.f, 0.f, 0.f, 0.f};
        cur = nxt; cA = nA; cB = nB; ++ui;
        if constexpr (ALIGN_EPI) { if (wr == 1) PG8_BAR; }
    }
    PG8_WAIT_V(0);
    if constexpr (!ALIGN_EPI) { if (wr == 0) PG8_BAR; }
    PG8_BAR;
    if constexpr (Epi::AFTER_DRAIN) { E.fused(acc, cur, wr, wc, fr, fq, lds, wid, lane); S.done(cur); }
#undef PG8_SA
#undef PG8_SB
#undef PG8_STAGE
#undef PG8_LDA
#undef PG8_LDB
#undef PG8_MMA
#undef PG8_WAIT_V
#undef PG8_WAIT_L
#undef PG8_BAR
#undef PG8_SCHED
}
}

namespace cg = cooperative_groups;
typedef unsigned short bf16_t;
typedef __bf16 bf16x2_t __attribute__((ext_vector_type(2)));

constexpr int DM = 2048, TLAT = 32768, TALL = 33280, SEQ = 16384, CTXL = 256;
constexpr int NP = 5376;
constexpr int PC_Q = 0, PC_K = 512, PC_V = 1024, PC_G = 2048, PC_U = 3072, PC_V2 = 4096, PC_LR = 5120;
constexpr float EPS = 1e-6f;
constexpr int NTHR = 512;
#ifndef GEMM_ALIGN_EPI
#define GEMM_ALIGN_EPI false
#endif
#ifndef GEMM_SP2
#define GEMM_SP2 true
#endif
constexpr int LDS_BYTES = 156160;
#ifndef PEER_NHI_SET
#define PEER_NHI_SET 4
#endif
constexpr int PEER_NHI = PEER_NHI_SET;

enum { I_X = 0, I_C, I_CTX, I_CCTX, I_N1G, I_N2G, I_WMOD, I_BMOD, I_WIN, I_WGU, I_BG, I_GNG, I_LNG, I_LNB, I_WS, I_BS, I_WOUT, I_WQ, I_SK, I_PU, I_PV, I_FNG, N_IN };

constexpr size_t WS_BAR   = 0;
constexpr size_t WS_BAR_BYTES = 16384;
constexpr size_t WS_MPART = WS_BAR_BYTES;
constexpr size_t WS_M     = WS_MPART + (size_t)32 * 3 * 12288 * 4;
constexpr size_t WS_BT1   = WS_M + (size_t)3 * 12288 * 4;
constexpr size_t WS_BT2   = WS_BT1 + (size_t)NP * DM * 2;
constexpr size_t WS_BT3   = WS_BT2 + (size_t)DM * DM * 2;
constexpr int    EROW     = 1536;
constexpr size_t WS_EU    = WS_BT3 + (size_t)2 * DM * DM * 2;
constexpr size_t WS_EV    = WS_EU + (size_t)16384 * EROW;
constexpr size_t WS_ESC   = WS_EV + (size_t)16384 * EROW;
constexpr int    EROW4    = 1024;
constexpr size_t WS_EU4   = WS_ESC + (size_t)4 * 16384 * 4;
constexpr size_t WS_EV4   = WS_EU4 + (size_t)16384 * EROW4;
constexpr size_t WS_A     = WS_EV4 + (size_t)16384 * EROW4;
constexpr size_t WS_P     = WS_A + (size_t)TALL * DM * 2;
constexpr size_t WS_H1    = WS_P;
constexpr int    GL_NS    = 260;
constexpr size_t WS_ST    = WS_P + (size_t)TALL * NP * 2;
constexpr size_t WS_Q     = WS_ST;
constexpr size_t WS_DEC   = WS_ST + (size_t)16 * GL_NS * 32768 * 2;
constexpr size_t WS_IDX   = WS_DEC + (size_t)16 * GL_NS * 128 * 4;
constexpr size_t WS_GATE  = WS_IDX + (size_t)TLAT * 128 * 4;
constexpr size_t WS_SSQ   = WS_GATE + (size_t)TLAT * 128 * 4;
constexpr size_t WS_CPART = WS_SSQ + (size_t)TLAT * 32 * 4;
constexpr size_t WS_CQ    = WS_CPART + (size_t)16 * 2 * 2048 * 4;
constexpr size_t WS_END   = WS_CQ + (size_t)2 * 2048 * 4;

struct Params {
    const float* in[N_IN];
    float* out;
    unsigned char* ws;
};

__device__ __forceinline__ float bf2f(unsigned short b) { return __uint_as_float(((unsigned)b) << 16); }
__device__ __forceinline__ float bflo(unsigned u) { return __uint_as_float(u << 16); }
__device__ __forceinline__ float bfhi(unsigned u) { return __uint_as_float(u & 0xffff0000u); }
typedef __bf16 bf16x2v_t __attribute__((ext_vector_type(2)));
typedef float f32x2v_t __attribute__((ext_vector_type(2)));
__device__ __forceinline__ unsigned pack2(float lo, float hi) { f32x2v_t f; f[0] = lo; f[1] = hi; return __builtin_bit_cast(unsigned, __builtin_convertvector(f, bf16x2v_t)); }
__device__ __forceinline__ unsigned short f2bf(float f) { return (unsigned short)(pack2(f, 0.f) & 0xffffu); }
__device__ __forceinline__ float wave_sum(float v) {
#pragma unroll
    for (int o = 32; o >= 1; o >>= 1) v += __shfl_xor(v, o);
    return v;
}
__device__ __forceinline__ float wave_max(float v) {
#pragma unroll
    for (int o = 32; o >= 1; o >>= 1) v = fmaxf(v, __shfl_xor(v, o));
    return v;
}
__device__ __forceinline__ float gelu_exact(float x) { return 0.5f * x * (1.0f + erff(x * 0.70710678118654752f)); }
__device__ __forceinline__ float silu_f(float x) { return x * __builtin_amdgcn_rcpf(1.0f + __expf(-x)); }
__device__ __forceinline__ float dot2bf(unsigned a, unsigned b, float c) { return __builtin_amdgcn_fdot2_f32_bf16(__builtin_bit_cast(bf16x2_t, a), __builtin_bit_cast(bf16x2_t, b), c, false); }
__device__ __forceinline__ void wave_lds_fence() { asm volatile("s_waitcnt lgkmcnt(0)" ::: "memory"); __builtin_amdgcn_wave_barrier(); }

constexpr int MOD_KS = 32;
__device__ void st_mod_partial(const Params& p, int bid, int nb) {
    const int lane = threadIdx.x & 63, wv = __builtin_amdgcn_readfirstlane(threadIdx.x >> 6);
    float* part = (float*)(p.ws + WS_MPART);
    const float* wm = p.in[I_WMOD];
    for (int it = bid * 8 + wv; it < MOD_KS * 48; it += nb * 8) {
        const int ks = it / 48, cc = it - ks * 48;
        const int k0 = ks * 64, n0 = cc * 256 + lane * 4;
        float4 a0 = {0.f, 0.f, 0.f, 0.f}, a1 = a0, a2 = a0;
        const int k = k0 + lane;
        const float s0 = silu_f(p.in[I_C][k]), s1 = silu_f(p.in[I_C][DM + k]), s2 = silu_f(p.in[I_CCTX][k]);
        const float* wrow = wm + (size_t)k0 * 12288 + n0;
#pragma unroll 16
        for (int j = 0; j < 64; ++j) {
            const float4 w = *(const float4*)(wrow + (size_t)j * 12288);
            const float t0 = __shfl(s0, j), t1 = __shfl(s1, j), t2 = __shfl(s2, j);
            a0.x += t0 * w.x; a0.y += t0 * w.y; a0.z += t0 * w.z; a0.w += t0 * w.w;
            a1.x += t1 * w.x; a1.y += t1 * w.y; a1.z += t1 * w.z; a1.w += t1 * w.w;
            a2.x += t2 * w.x; a2.y += t2 * w.y; a2.z += t2 * w.z; a2.w += t2 * w.w;
        }
        *(float4*)(part + (size_t)(ks * 3 + 0) * 12288 + n0) = a0;
        *(float4*)(part + (size_t)(ks * 3 + 1) * 12288 + n0) = a1;
        *(float4*)(part + (size_t)(ks * 3 + 2) * 12288 + n0) = a2;
    }
}
__device__ void st_mod_final(const Params& p, int bid, int nb) {
    const float* part = (const float*)(p.ws + WS_MPART);
    float* M = (float*)(p.ws + WS_M);
    for (int i = bid * NTHR + threadIdx.x; i < 3 * 12288; i += nb * NTHR) {
        const int r = i / 12288, n = i - r * 12288;
        float s = p.in[I_BMOD][n];
#pragma unroll
        for (int ks = 0; ks < MOD_KS; ++ks) s += part[(size_t)(ks * 3 + r) * 12288 + n];
        M[i] = s;
    }
}

struct WprepItem { const float* W; int ldw; bf16_t* Bt; int kt, nt, mode; };
__device__ __forceinline__ WprepItem wprep_item(const Params& p, int it) {
    WprepItem w;
    if (it < 1344) { w.W = p.in[I_WIN]; w.ldw = 5152; w.Bt = (bf16_t*)(p.ws + WS_BT1); w.kt = it & 15; w.nt = it >> 4; w.mode = 1; }
    else { const int j = it - 1344; w.W = p.in[I_WOUT]; w.ldw = DM; w.Bt = (bf16_t*)(p.ws + WS_BT2); w.kt = j & 15; w.nt = j >> 4; w.mode = 0; }
    return w;
}
__device__ __forceinline__ void wprep_load(const WprepItem& w, float4 (&v)[4]) {
    const int tid = threadIdx.x, r = tid >> 4, c4 = tid & 15;
    const int nd = w.nt * 64 + c4 * 4;
    int sc = nd; bool valid = true;
    if (w.mode == 1) { if (nd < 3072) sc = nd; else if (nd < 5120) sc = nd + 32; else if (nd < 5152) sc = 3072 + (nd - 5120); else { sc = 0; valid = false; } }
#pragma unroll
    for (int i = 0; i < 4; ++i) {
        v[i] = make_float4(0.f, 0.f, 0.f, 0.f);
        if (valid) v[i] = *(const float4*)(w.W + (size_t)(w.kt * 128 + r + 32 * i) * w.ldw + sc);
    }
}
__device__ void st_wprep(const Params& p, int bid, int nb, unsigned char* smem) {
    unsigned short* tl = (unsigned short*)smem;
    const int tid = threadIdx.x, r = tid >> 4, c4 = tid & 15;
    const int NIT = 1344 + 512;
    float4 v[4];
    int it = bid;
    if (it < NIT) wprep_load(wprep_item(p, it), v);
    for (; it < NIT; it += nb) {
        const WprepItem w = wprep_item(p, it);
#pragma unroll
        for (int i = 0; i < 4; ++i) {
            const int kl = r + 32 * i;
            tl[(c4 * 4 + 0) * 136 + kl] = f2bf(v[i].x); tl[(c4 * 4 + 1) * 136 + kl] = f2bf(v[i].y);
            tl[(c4 * 4 + 2) * 136 + kl] = f2bf(v[i].z); tl[(c4 * 4 + 3) * 136 + kl] = f2bf(v[i].w);
        }
        __syncthreads();
        if (it + nb < NIT) wprep_load(wprep_item(p, it + nb), v);
        {
            const int n = tid >> 3, seg = tid & 7;
            const uint4* src = (const uint4*)(tl + n * 136 + seg * 16);
            const uint4 v0 = src[0], v1 = src[1];
            uint4* dst = (uint4*)(w.Bt + (size_t)(w.nt * 64 + n) * DM + w.kt * 128 + seg * 16);
            dst[0] = v0; dst[1] = v1;
        }
        __syncthreads();
    }
}

__device__ void st_wprep_q(const Params& p, int bid, int nb, unsigned char* smem) {
    unsigned short* tl = (unsigned short*)smem;
    float* red = (float*)(smem + 2 * 64 * 136 * 2);
    const int tid = threadIdx.x, r = tid >> 4, c4 = tid & 15;
    const float* M = (const float*)(p.ws + WS_M);
    float* CP = (float*)(p.ws + WS_CPART);
    bf16_t* Bt = (bf16_t*)(p.ws + WS_BT3);
    for (int it = bid; it < 512; it += nb) {
        const int kt = it & 15, nt = it >> 4;
        float4 v[4]; float gs[2][4], sh[2][4];
#pragma unroll
        for (int i = 0; i < 4; ++i) {
            const int k = kt * 128 + r + 32 * i;
            v[i] = *(const float4*)(p.in[I_WQ] + (size_t)k * DM + nt * 64 + c4 * 4);
            const float g = p.in[I_N2G][k];
#pragma unroll
            for (int b = 0; b < 2; ++b) { gs[b][i] = g * (1.0f + M[(size_t)b * 12288 + 4 * DM + k]); sh[b][i] = M[(size_t)b * 12288 + 3 * DM + k]; }
        }
#pragma unroll
        for (int b = 0; b < 2; ++b) {
            float4 pc = make_float4(0.f, 0.f, 0.f, 0.f);
#pragma unroll
            for (int i = 0; i < 4; ++i) {
                const int kl = r + 32 * i;
                unsigned short* t0 = tl + b * (64 * 136) + (c4 * 4) * 136 + kl;
                t0[0] = f2bf(v[i].x * gs[b][i]); t0[136] = f2bf(v[i].y * gs[b][i]); t0[2 * 136] = f2bf(v[i].z * gs[b][i]); t0[3 * 136] = f2bf(v[i].w * gs[b][i]);
                pc.x += sh[b][i] * v[i].x; pc.y += sh[b][i] * v[i].y; pc.z += sh[b][i] * v[i].z; pc.w += sh[b][i] * v[i].w;
            }
            *(float4*)(red + (b * 32 + r) * 64 + c4 * 4) = pc;
        }
        __syncthreads();
        {
            const int n = tid >> 3, seg = tid & 7;
#pragma unroll
            for (int b = 0; b < 2; ++b) {
                const uint4* src = (const uint4*)(tl + b * (64 * 136) + n * 136 + seg * 16);
                const uint4 v0 = src[0], v1 = src[1];
                uint4* dst = (uint4*)(Bt + (size_t)(b * DM + nt * 64 + n) * DM + kt * 128 + seg * 16);
                dst[0] = v0; dst[1] = v1;
            }
            if (tid < 128) {
                const int b = tid >> 6, col = tid & 63;
                float sum = 0.f;
#pragma unroll
                for (int rr = 0; rr < 32; ++rr) sum += red[(b * 32 + rr) * 64 + col];
                CP[(size_t)(kt * 2 + b) * DM + nt * 64 + col] = sum;
            }
        }
        __syncthreads();
    }
}
__device__ void st_cq_final(const Params& p, int bid) {
    const int i = bid * NTHR + threadIdx.x;
    if (i < 2 * DM) {
        const float* CP = (const float*)(p.ws + WS_CPART);
        const int b = i >> 11, n = i & (DM - 1);
        float sum = 0.f;
#pragma unroll
        for (int kt = 0; kt < 16; ++kt) sum += CP[(size_t)(kt * 2 + b) * DM + n];
        ((float*)(p.ws + WS_CQ))[i] = sum;
    }
}
typedef float f32x2_t __attribute__((ext_vector_type(2)));
typedef float v16f_t __attribute__((ext_vector_type(16)));
typedef float v32f_t __attribute__((ext_vector_type(32)));
typedef unsigned v6u_t __attribute__((ext_vector_type(6)));
__device__ void st_econv(const Params& p, int bid, int nb) {
    const int lane = threadIdx.x & 63, wv = __builtin_amdgcn_readfirstlane(threadIdx.x >> 6);
    float* esc = (float*)(p.ws + WS_ESC);
    float4 nx[8];
    {
        const int row0 = bid * 8 + wv;
        const float* src0 = ((row0 >> 14) ? p.in[I_PV] : p.in[I_PU]) + (size_t)(row0 & 16383) * DM + lane * 32;
#pragma unroll
        for (int q = 0; q < 8; ++q) nx[q] = row0 < 2 * 16384 ? *(const float4*)(src0 + q * 4) : make_float4(0.f, 0.f, 0.f, 0.f);
    }
    for (int row = bid * 8 + wv; row < 2 * 16384; row += nb * 8) {
        const int tbl = row >> 14, r = row & 16383;
        float x[32];
        float m = 0.f;
#pragma unroll
        for (int q = 0; q < 8; ++q) {
            const float4 a = nx[q];
            x[q * 4 + 0] = a.x; x[q * 4 + 1] = a.y; x[q * 4 + 2] = a.z; x[q * 4 + 3] = a.w;
            m = fmaxf(m, fmaxf(fmaxf(fabsf(a.x), fabsf(a.y)), fmaxf(fabsf(a.z), fabsf(a.w))));
        }
        {
            const int rown = row + nb * 8;
            if (rown < 2 * 16384) {
                const float* srcn = ((rown >> 14) ? p.in[I_PV] : p.in[I_PU]) + (size_t)(rown & 16383) * DM + lane * 32;
#pragma unroll
                for (int q = 0; q < 8; ++q) nx[q] = *(const float4*)(srcn + q * 4);
            }
        }
        m = wave_max(m);
        if (PEER_NHI > 0) {
        const float sc = m > 0.f ? 7.5f / m : 1.0f;
        if (lane == 0) esc[tbl * 16384 + r] = m > 0.f ? m / 7.5f : 1.0f;
        v16f_t va, vb;
#pragma unroll
        for (int i = 0; i < 16; ++i) { va[i] = x[2 * i] * sc; vb[i] = x[2 * i + 1] * sc; }
        const v6u_t pk = __builtin_amdgcn_cvt_scalef32_2xpk16_fp6_f32(va, vb, 1.0f);
        unsigned char* dst = p.ws + (tbl ? WS_EV : WS_EU) + (size_t)r * EROW;
        uint4 o; o.x = pk[0]; o.y = pk[1]; o.z = pk[2]; o.w = pk[3];
        uint2 o2; o2.x = pk[4]; o2.y = pk[5];
        *(uint4*)(dst + lane * 16) = o;
        *(uint2*)(dst + 1024 + lane * 8) = o2;
        }
        float best = 3.0e38f, bscale = 1.0f;
#pragma unroll
        for (int ci = 0; ci < 4; ++ci) {
            const float cr = 1.0f - 0.125f * ci;
            const float inv4 = m > 0.f ? (cr * m) / 6.0f : 1.0f, sc4 = 1.0f / inv4;
            float err = 0.f;
#pragma unroll
            for (int q = 0; q < 4; ++q) {
                const unsigned wq = __builtin_amdgcn_cvt_scalef32_pk_fp4_f32(0u, x[q * 8 + 0] * sc4, x[q * 8 + 1] * sc4, 1.0f, 0);
                const f32x2_t d0 = __builtin_amdgcn_cvt_scalef32_pk_f32_fp4(wq, 1.0f, 0);
                float e;
                e = x[q * 8 + 0] - d0[0] * inv4; err += e * e; e = x[q * 8 + 1] - d0[1] * inv4; err += e * e;
            }
            err = wave_sum(err);
            if (err < best) { best = err; bscale = inv4; }
        }
        unsigned w4[4];
        {
            const float sc4 = 1.0f / bscale;
#pragma unroll
            for (int q = 0; q < 4; ++q) {
                unsigned wq = 0u;
                wq = __builtin_amdgcn_cvt_scalef32_pk_fp4_f32(wq, x[q * 8 + 0] * sc4, x[q * 8 + 1] * sc4, 1.0f, 0);
                wq = __builtin_amdgcn_cvt_scalef32_pk_fp4_f32(wq, x[q * 8 + 2] * sc4, x[q * 8 + 3] * sc4, 1.0f, 1);
                wq = __builtin_amdgcn_cvt_scalef32_pk_fp4_f32(wq, x[q * 8 + 4] * sc4, x[q * 8 + 5] * sc4, 1.0f, 2);
                wq = __builtin_amdgcn_cvt_scalef32_pk_fp4_f32(wq, x[q * 8 + 6] * sc4, x[q * 8 + 7] * sc4, 1.0f, 3);
                w4[q] = wq;
            }
        }
        if (lane == 0) esc[(2 + tbl) * 16384 + r] = bscale;
        uint4 o4; o4.x = w4[0]; o4.y = w4[1]; o4.z = w4[2]; o4.w = w4[3];
        *(uint4*)(p.ws + (tbl ? WS_EV4 : WS_EU4) + (size_t)r * EROW4 + lane * 16) = o4;
    }
}

__device__ void st_normmod(const Params& p, const float* src_lat, const float* src_ctx, int nrows, const float* gvec, int sh_off, int sc_off, int bid, int nb, const bf16_t* src_bf16 = nullptr) {
    const int lane = threadIdx.x & 63, wv = __builtin_amdgcn_readfirstlane(threadIdx.x >> 6);
    const float* M = (const float*)(p.ws + WS_M);
    bf16_t* A = (bf16_t*)(p.ws + WS_A);
    for (int row = bid * 8 + wv; row < nrows; row += nb * 8) {
        const float* src = row < TLAT ? src_lat + (size_t)row * DM : src_ctx + (size_t)(row - TLAT) * DM;
        const int mrow = row < TLAT ? (row >> 14) : 2;
        float v[32];
        float ss = 0.f;
        if (src_bf16) {
#pragma unroll
            for (int i = 0; i < 4; ++i) {
                const uint4 d = *(const uint4*)(src_bf16 + (size_t)row * DM + i * 512 + lane * 8);
                v[i * 8 + 0] = bflo(d.x); v[i * 8 + 1] = bfhi(d.x); v[i * 8 + 2] = bflo(d.y); v[i * 8 + 3] = bfhi(d.y);
                v[i * 8 + 4] = bflo(d.z); v[i * 8 + 5] = bfhi(d.z); v[i * 8 + 6] = bflo(d.w); v[i * 8 + 7] = bfhi(d.w);
            }
        } else {
#pragma unroll
        for (int i = 0; i < 4; ++i) {
            const float4 a = *(const float4*)(src + i * 512 + lane * 8), b = *(const float4*)(src + i * 512 + lane * 8 + 4);
            v[i * 8 + 0] = a.x; v[i * 8 + 1] = a.y; v[i * 8 + 2] = a.z; v[i * 8 + 3] = a.w;
            v[i * 8 + 4] = b.x; v[i * 8 + 5] = b.y; v[i * 8 + 6] = b.z; v[i * 8 + 7] = b.w;
        }
        }
#pragma unroll
        for (int j = 0; j < 32; ++j) ss += v[j] * v[j];
        ss = wave_sum(ss);
        const float rstd = rsqrtf(ss * (1.0f / DM) + EPS);
        const float* mp = M + (size_t)mrow * 12288;
        uint4 wout[4];
#pragma unroll
        for (int i = 0; i < 4; ++i) {
            const int c0 = i * 512 + lane * 8;
            float o[8];
#pragma unroll
            for (int hh = 0; hh < 2; ++hh) {
                const float4 g = *(const float4*)(gvec + c0 + hh * 4), sc = *(const float4*)(mp + sc_off + c0 + hh * 4), sh = *(const float4*)(mp + sh_off + c0 + hh * 4);
                o[hh * 4 + 0] = v[i * 8 + hh * 4 + 0] * rstd * g.x * (1.f + sc.x) + sh.x;
                o[hh * 4 + 1] = v[i * 8 + hh * 4 + 1] * rstd * g.y * (1.f + sc.y) + sh.y;
                o[hh * 4 + 2] = v[i * 8 + hh * 4 + 2] * rstd * g.z * (1.f + sc.z) + sh.z;
                o[hh * 4 + 3] = v[i * 8 + hh * 4 + 3] * rstd * g.w * (1.f + sc.w) + sh.w;
            }
            wout[i].x = pack2(o[0], o[1]); wout[i].y = pack2(o[2], o[3]); wout[i].z = pack2(o[4], o[5]); wout[i].w = pack2(o[6], o[7]);
        }
#pragma unroll
        for (int i = 0; i < 4; ++i) *(uint4*)(A + (size_t)row * DM + i * 512 + lane * 8) = wout[i];
    }
}

struct EpiP {
    static constexpr bool PERM = true, AFTER_DRAIN = false;
    bf16_t* O; int ldc;
    __device__ __forceinline__ int btile(const pg8::Unit& u) const { return u.pn; }
    __device__ __forceinline__ void operator()(const pg8::f32x4 (&acc)[2][2][4][2], const pg8::Unit& u, int wr, int wc, int fr, int fq) const {
        using namespace pg8;
        const int row0 = u.pm * BM + wr * 64 + fr; const int col0 = u.pn * BM + wc * 32 + 8 * fq;
        const bool act = (u.pn >= 12) && (u.pn < 20);
#pragma unroll
        for (int ai = 0; ai < 2; ++ai)
#pragma unroll
            for (int m = 0; m < 4; ++m) { bf16_t* rowp = O + (size_t)(row0 + ai * HALF + m * 16) * ldc + col0;
#pragma unroll
                for (int bj = 0; bj < 2; ++bj) { f32x4 v0 = acc[ai][bj][m][0], v1 = acc[ai][bj][m][1];
                    if (act) { f32x2 a = gelu_pk((f32x2){v0[0], v0[1]}), b = gelu_pk((f32x2){v0[2], v0[3]}), c = gelu_pk((f32x2){v1[0], v1[1]}), d = gelu_pk((f32x2){v1[2], v1[3]});
                        v0 = (f32x4){a.x, a.y, b.x, b.y}; v1 = (f32x4){c.x, c.y, d.x, d.y}; }
                    u32x4 w; w.x = cvt_pk_bf16(v0[0], v0[1]); w.y = cvt_pk_bf16(v0[2], v0[3]); w.z = cvt_pk_bf16(v1[0], v1[1]); w.w = cvt_pk_bf16(v1[2], v1[3]);
                    *(u32x4*)(rowp + bj * HALF) = w; } }
    }
};
struct EpiQ {
    static constexpr bool PERM = true, AFTER_DRAIN = false;
    bf16_t* O; const float* SSQ; const float* CQ;
    __device__ __forceinline__ int btile(const pg8::Unit& u) const { return u.pn + (u.pm >= 64 ? 8 : 0); }
    __device__ __forceinline__ void operator()(const pg8::f32x4 (&acc)[2][2][4][2], const pg8::Unit& u, int wr, int wc, int fr, int fq) const {
        using namespace pg8;
        const int row0 = u.pm * BM + wr * 64 + fr, col0 = u.pn * BM + wc * 32 + 8 * fq;
        const float* cq = CQ + (size_t)(u.pm >= 64 ? 1 : 0) * DM + col0;
        f32x4 cv[2][2];
#pragma unroll
        for (int bj = 0; bj < 2; ++bj)
#pragma unroll
            for (int n = 0; n < 2; ++n) cv[bj][n] = *(const f32x4*)(cq + bj * HALF + 4 * n);
        float rs[2][4];
#pragma unroll
        for (int ai = 0; ai < 2; ++ai)
#pragma unroll
            for (int m = 0; m < 4; ++m) {
                const float* sp = SSQ + (size_t)(row0 + ai * HALF + m * 16) * 32 + fq * 8;
                const f32x4 a = *(const f32x4*)sp, b = *(const f32x4*)(sp + 4);
                float t = (a[0] + a[1]) + (a[2] + a[3]) + (b[0] + b[1]) + (b[2] + b[3]);
                t += __shfl_xor(t, 16); t += __shfl_xor(t, 32);
                rs[ai][m] = rsqrtf(t * (1.0f / DM) + EPS);
            }
#pragma unroll
        for (int ai = 0; ai < 2; ++ai)
#pragma unroll
            for (int m = 0; m < 4; ++m) { bf16_t* rowp = O + (size_t)(row0 + ai * HALF + m * 16) * DM + col0;
#pragma unroll
                for (int bj = 0; bj < 2; ++bj) { const f32x4 v0 = acc[ai][bj][m][0] * rs[ai][m] + cv[bj][0], v1 = acc[ai][bj][m][1] * rs[ai][m] + cv[bj][1];
                    u32x4 w; w.x = cvt_pk_bf16(v0[0], v0[1]); w.y = cvt_pk_bf16(v0[2], v0[3]); w.z = cvt_pk_bf16(v1[0], v1[1]); w.w = cvt_pk_bf16(v1[2], v1[3]);
                    *(u32x4*)(rowp + bj * HALF) = w; } }
    }
};
struct EpiH1 {
    static constexpr bool PERM = true, AFTER_DRAIN = false;
    bf16_t* C; const float* X; const float* Mv; float* SSQ;
    __device__ __forceinline__ int btile(const pg8::Unit& u) const { return u.pn; }
    __device__ __forceinline__ void operator()(const pg8::f32x4 (&acc)[2][2][4][2], const pg8::Unit& u, int wr, int wc, int fr, int fq) const {
        using namespace pg8;
        const int row0 = u.pm * BM + wr * 64 + fr, col0 = u.pn * BM + wc * 32 + 8 * fq;
        const float* g1 = Mv + (size_t)(u.pm >= 64 ? 1 : 0) * 12288 + 2 * DM;
        f32x4 gv[2][2];
#pragma unroll
        for (int bj = 0; bj < 2; ++bj)
#pragma unroll
            for (int n = 0; n < 2; ++n) gv[bj][n] = *(const f32x4*)(g1 + col0 + bj * HALF + 4 * n);
#pragma unroll
        for (int ai = 0; ai < 2; ++ai) {
            f32x4 xv[4][2][2];
#pragma unroll
            for (int m = 0; m < 4; ++m)
#pragma unroll
                for (int bj = 0; bj < 2; ++bj)
#pragma unroll
                    for (int n = 0; n < 2; ++n) xv[m][bj][n] = *(const f32x4*)(X + (size_t)(row0 + ai * HALF + m * 16) * DM + col0 + bj * HALF + 4 * n);
#pragma unroll
            for (int m = 0; m < 4; ++m) {
                float ssq = 0.f;
#pragma unroll
                for (int bj = 0; bj < 2; ++bj) {
                    const f32x4 v0 = xv[m][bj][0] + gv[bj][0] * acc[ai][bj][m][0], v1 = xv[m][bj][1] + gv[bj][1] * acc[ai][bj][m][1];
                    ssq += (v0[0] * v0[0] + v0[1] * v0[1]) + (v0[2] * v0[2] + v0[3] * v0[3]) + (v1[0] * v1[0] + v1[1] * v1[1]) + (v1[2] * v1[2] + v1[3] * v1[3]);
                    u32x4 w; w.x = cvt_pk_bf16(v0[0], v0[1]); w.y = cvt_pk_bf16(v0[2], v0[3]); w.z = cvt_pk_bf16(v1[0], v1[1]); w.w = cvt_pk_bf16(v1[2], v1[3]);
                    *(u32x4*)(C + (size_t)(row0 + ai * HALF + m * 16) * DM + col0 + bj * HALF) = w;
                }
                ssq += __shfl_xor(ssq, 16); ssq += __shfl_xor(ssq, 32);
                if (fq == 0) SSQ[(size_t)(row0 + ai * HALF + m * 16) * 32 + u.pn * 4 + wc] = ssq;
            }
        }
    }
};

typedef short bf16x8_t __attribute__((ext_vector_type(8)));
typedef short s16x4_t __attribute__((ext_vector_type(4)));
typedef float f32x4_t __attribute__((ext_vector_type(4)));
typedef float f32x16_t __attribute__((ext_vector_type(16)));
#define LDSP(T, off) ((__attribute__((address_space(3))) T*)(lds3 + (off)))
constexpr int GL_RAWQ = 0, GL_RAWK = 16384, GL_LR = 32768, GL_V = 40960, GL_X = 77824, GL_TOT = 147456, GL_SS = 149504;
constexpr int GL_P = GL_RAWQ, GL_OBUF = GL_X;
constexpr int GL_VS = 288;
constexpr int GL_XS = 136;
constexpr int GL_KS = 72;
constexpr float GL_QSCALE = 0.08838834764831845f;

typedef unsigned u32x4_t __attribute__((ext_vector_type(4)));
typedef unsigned u32x2_t __attribute__((ext_vector_type(2)));
struct GlaRaw { u32x4_t q0, q1, k0, k1, v0, v1, v2, v3; u32x2_t lr; float w0, w1, w2, w3, w4, w5, w6, w7; float bg; };
template <bool NEED_Q>
__device__ __forceinline__ void gla_fetch(const Params& p, GlaRaw& R, size_t row0, int h) {
    const int tid = threadIdx.x;
    const bf16_t* P = (const bf16_t*)(p.ws + WS_P);
    const int j = tid >> 3, part = tid & 7;
    const bf16_t* pr = P + (row0 + j) * NP;
    if (NEED_Q) { const u32x4_t* s4 = (const u32x4_t*)(pr + PC_Q + h * 128 + part * 16); R.q0 = s4[0]; R.q1 = s4[1]; }
    { const u32x4_t* s4 = (const u32x4_t*)(pr + PC_K + h * 128 + part * 16); R.k0 = s4[0]; R.k1 = s4[1]; }
    { const u32x4_t* s4 = (const u32x4_t*)(pr + PC_V + h * 256 + part * 32); R.v0 = s4[0]; R.v1 = s4[1]; R.v2 = s4[2]; R.v3 = s4[3]; }
    R.lr = *(const u32x2_t*)(pr + PC_LR + part * 4);
    const int lane = tid & 63, wv = tid >> 6, dir = wv >> 2, d = (wv & 3) * 32 + (lane & 31), hh = lane >> 5;
    const float* wg = p.in[I_WGU] + (size_t)(dir * 16 + 8 * hh) * 512 + h * 128 + d;
    R.w0 = wg[0]; R.w1 = wg[512]; R.w2 = wg[1024]; R.w3 = wg[1536]; R.w4 = wg[2048]; R.w5 = wg[2560]; R.w6 = wg[3072]; R.w7 = wg[3584];
    R.bg = p.in[I_BG][dir * 512 + h * 128 + d];
}
template <bool NEED_Q>
__device__ __forceinline__ void gla_commit(unsigned char* smem, const GlaRaw& R, uint4& bw, float& bg) {
    const int tid = threadIdx.x, j = tid >> 3, part = tid & 7;
    PG8_LAS unsigned char* lds3 = (PG8_LAS unsigned char*)smem;
    if (NEED_Q) { *LDSP(u32x4_t, GL_RAWQ + (j * 128 + part * 16) * 2) = R.q0; *LDSP(u32x4_t, GL_RAWQ + (j * 128 + part * 16) * 2 + 16) = R.q1; }
    *LDSP(u32x4_t, GL_RAWK + (j * 128 + part * 16) * 2) = R.k0; *LDSP(u32x4_t, GL_RAWK + (j * 128 + part * 16) * 2 + 16) = R.k1;
    { const unsigned vo = GL_V + (j * GL_VS + part * 32) * 2; *LDSP(u32x4_t, vo) = R.v0; *LDSP(u32x4_t, vo + 16) = R.v1; *LDSP(u32x4_t, vo + 32) = R.v2; *LDSP(u32x4_t, vo + 48) = R.v3; }
    *LDSP(u32x2_t, GL_LR + (j * 32 + part * 4) * 2) = R.lr;
    bw.x = pack2(R.w0, R.w1); bw.y = pack2(R.w2, R.w3); bw.z = pack2(R.w4, R.w5); bw.w = pack2(R.w6, R.w7); bg = R.bg;
}
__device__ __forceinline__ void gla_z(unsigned char* smem, const uint4 bw, const float bg) {
    PG8_LAS unsigned char* lds3 = (PG8_LAS unsigned char*)smem;
    const int tid = threadIdx.x, lane = tid & 63, wv = __builtin_amdgcn_readfirstlane(tid >> 6);
    const int dir = wv >> 2, r = lane & 31, hh = lane >> 5, d = (wv & 3) * 32 + r;
    const bf16x8_t bfr = __builtin_bit_cast(bf16x8_t, bw);
#pragma unroll
    for (int mt = 0; mt < 2; ++mt) {
        const bf16x8_t afr = *LDSP(bf16x8_t, GL_LR + ((mt * 32 + r) * 32 + dir * 16 + 8 * hh) * 2);
        f32x16_t acc;
#pragma unroll
        for (int i = 0; i < 16; ++i) acc[i] = 0.f;
        acc = __builtin_amdgcn_mfma_f32_32x32x16_bf16(afr, bfr, acc, 0, 0, 0);
#pragma unroll
        for (int reg = 0; reg < 16; ++reg) {
            const int t = mt * 32 + (reg & 3) + 8 * (reg >> 2) + 4 * hh;
            *LDSP(float, GL_X + ((dir * 64 + t) * 128 + d) * 4) = acc[reg] + bg;
        }
    }
}
template <bool PASS_A>
__device__ __forceinline__ void gla_prep(unsigned char* smem, float* dec_f, float* dec_b) {
    PG8_LAS unsigned char* lds3 = (PG8_LAS unsigned char*)smem;
    const int tid = threadIdx.x, dp = tid & 63, wv = __builtin_amdgcn_readfirstlane(tid >> 6), dir = wv & 1, tq = wv >> 1;
    float la0[16], la1[16];
    {
        unsigned bz = GL_X + ((dir * 64 + tq * 16) * 128 + 2 * dp) * 4; asm volatile("" : "+v"(bz));
#pragma unroll
        for (int tt = 0; tt < 16; ++tt) { const f32x2_t z = *LDSP(f32x2_t, bz + tt * 512); la0[tt] = z[0]; la1[tt] = z[1]; }
    }
#pragma unroll
    for (int tt = 0; tt < 16; ++tt) {
        const float z0 = la0[tt], z1 = la1[tt];
        la0[tt] = (fminf(z0, 0.f) - __logf(1.0f + __expf(-fabsf(z0)))) * (1.0f / 16.0f);
        la1[tt] = (fminf(z1, 0.f) - __logf(1.0f + __expf(-fabsf(z1)))) * (1.0f / 16.0f);
    }
    float run0 = 0.f, run1 = 0.f;
    if (dir == 0) {
#pragma unroll
        for (int tt = 0; tt < 16; ++tt) { run0 += la0[tt]; la0[tt] = run0; run1 += la1[tt]; la1[tt] = run1; }
    } else {
#pragma unroll
        for (int tt = 15; tt >= 0; --tt) { run0 += la0[tt]; la0[tt] = run0; run1 += la1[tt]; la1[tt] = run1; }
    }
    { f32x2_t rr; rr[0] = run0; rr[1] = run1; *LDSP(f32x2_t, GL_TOT + ((tq * 2 + dir) * 128 + 2 * dp) * 4) = rr; }
    __syncthreads();
    float tot0 = 0.f, tot1 = 0.f, off0 = 0.f, off1 = 0.f;
#pragma unroll
    for (int q = 0; q < 4; ++q) {
        const f32x2_t tv = *LDSP(f32x2_t, GL_TOT + ((q * 2 + dir) * 128 + 2 * dp) * 4);
        tot0 += tv[0]; tot1 += tv[1];
        if (dir == 0 ? (q < tq) : (q > tq)) { off0 += tv[0]; off1 += tv[1]; }
    }
    if (PASS_A) {
        if (tq == 0) { float2 dv; dv.x = __expf(tot0); dv.y = __expf(tot1); *(float2*)((dir ? dec_b : dec_f) + 2 * dp) = dv; }
        unsigned w0[8], w1[8];
        unsigned bk = GL_RAWK + ((tq * 16) * 128 + 2 * dp) * 2; asm volatile("" : "+v"(bk));
#pragma unroll
        for (int t2 = 0; t2 < 8; ++t2) {
            const unsigned ka = *LDSP(unsigned, bk + (2 * t2) * 256), kb = *LDSP(unsigned, bk + (2 * t2 + 1) * 256);
            const float ca0 = tot0 - (la0[2 * t2] + off0), ca1 = tot1 - (la1[2 * t2] + off1), cb0 = tot0 - (la0[2 * t2 + 1] + off0), cb1 = tot1 - (la1[2 * t2 + 1] + off1);
            w0[t2] = pack2(bflo(ka) * __expf(ca0), bflo(kb) * __expf(cb0));
            w1[t2] = pack2(bfhi(ka) * __expf(ca1), bfhi(kb) * __expf(cb1));
        }
        const int slot0 = (dp & 1) * 64 + (dp >> 1);
        const unsigned bo = GL_X + dir * (128 * GL_KS * 2) + (slot0 * GL_KS + tq * 16) * 2;
        *LDSP(u32x4_t, bo) = (u32x4_t){w0[0], w0[1], w0[2], w0[3]}; *LDSP(u32x4_t, bo + 16) = (u32x4_t){w0[4], w0[5], w0[6], w0[7]};
        *LDSP(u32x4_t, bo + 32 * GL_KS * 2) = (u32x4_t){w1[0], w1[1], w1[2], w1[3]}; *LDSP(u32x4_t, bo + 32 * GL_KS * 2 + 16) = (u32x4_t){w1[4], w1[5], w1[6], w1[7]};
    } else {
        unsigned bq = GL_RAWQ + ((tq * 16) * 128 + 2 * dp) * 2; asm volatile("" : "+v"(bq));
        unsigned bx = GL_X + dir * (2 * 64 * GL_XS * 2) + ((tq * 16) * GL_XS + 2 * dp) * 2; asm volatile("" : "+v"(bx));
        unsigned qq[16], kk[16];
#pragma unroll
        for (int tt = 0; tt < 16; ++tt) { qq[tt] = *LDSP(unsigned, bq + tt * 256); kk[tt] = *LDSP(unsigned, bq + (GL_RAWK - GL_RAWQ) + tt * 256); }
#pragma unroll
        for (int tt = 0; tt < 16; ++tt) {
            const float c0 = la0[tt] + off0, c1 = la1[tt] + off1;
            *LDSP(unsigned, bx + tt * (GL_XS * 2)) = pack2(bflo(qq[tt]) * (GL_QSCALE * __expf(c0)), bfhi(qq[tt]) * (GL_QSCALE * __expf(c1)));
            *LDSP(unsigned, bx + 64 * GL_XS * 2 + tt * (GL_XS * 2)) = pack2(bflo(kk[tt]) * __expf(-c0), bfhi(kk[tt]) * __expf(-c1));
        }
    }
}
__device__ __forceinline__ bf16x8_t gla_vt_frag(PG8_LAS unsigned char* lds3, int e0, int ks, int lane) {
    const int g = lane >> 4, li = lane & 15, q = li >> 2, pp = li & 3;
    unsigned bv = GL_V + ((8 * (g >> 1) + q) * GL_VS + e0 + 16 * (g & 1) + 4 * pp) * 2; asm volatile("" : "+v"(bv));
    const s16x4_t lo = __builtin_amdgcn_ds_read_tr16_b64_v4i16(LDSP(s16x4_t, bv + ks * (16 * GL_VS * 2)));
    const s16x4_t hi = __builtin_amdgcn_ds_read_tr16_b64_v4i16(LDSP(s16x4_t, bv + ks * (16 * GL_VS * 2) + 4 * GL_VS * 2));
    return __builtin_shufflevector(lo, hi, 0, 1, 2, 3, 4, 5, 6, 7);
}
struct GlaItem { int b, h, c, isctx; size_t row0; int sf, sb; };
__device__ __forceinline__ GlaItem gla_item(int item) {
    GlaItem it;
    if (item < 2048) { it.isctx = 0; it.b = item >> 10; it.h = (item >> 8) & 3; it.c = item & 255; it.row0 = (size_t)it.b * SEQ + it.c * 64; it.sf = 4 + it.c; it.sb = 4 + (255 - it.c); }
    else { const int j = item - 2048; it.isctx = 1; it.b = j >> 4; it.h = (j >> 2) & 3; it.c = j & 3; it.row0 = (size_t)TLAT + it.b * CTXL + it.c * 64; it.sf = it.c; it.sb = 3 - it.c; }
    return it;
}
__device__ void st_gla_passA(const Params& p, int bid, int nb, unsigned char* smem) {
    PG8_LAS unsigned char* lds3 = (PG8_LAS unsigned char*)smem;
    const int tid = threadIdx.x, lane = tid & 63, wv = __builtin_amdgcn_readfirstlane(tid >> 6);
    bf16_t* ST = (bf16_t*)(p.ws + WS_ST);
    float* DEC = (float*)(p.ws + WS_DEC);
    GlaRaw R; uint4 bw = make_uint4(0u, 0u, 0u, 0u); float bg = 0.f;
    __syncthreads();
    if (bid < 2080) { const GlaItem it0 = gla_item(bid); gla_fetch<false>(p, R, it0.row0, it0.h); gla_commit<false>(smem, R, bw, bg); }
    for (int item = bid; item < 2080; item += nb) {
        const GlaItem it = gla_item(item);
        const int chf = it.b * 8 + it.h * 2, chb = chf + 1;
        const bool has_next = item + nb < 2080;
        __syncthreads();
        if (has_next) { const GlaItem itn = gla_item(item + nb); gla_fetch<false>(p, R, itn.row0, itn.h); }
        __builtin_amdgcn_sched_barrier(0);
        gla_z(smem, bw, bg);
        __syncthreads();
        gla_prep<true>(smem, DEC + ((size_t)chf * GL_NS + it.sf) * 128, DEC + ((size_t)chb * GL_NS + it.sb) * 128);
        __syncthreads();
        const int e0 = wv * 32, r = lane & 31, hh = lane >> 5;
        bf16x8_t va[4];
#pragma unroll
        for (int ks = 0; ks < 4; ++ks) va[ks] = gla_vt_frag(lds3, e0, ks, lane);
#pragma unroll
        for (int dir = 0; dir < 2; ++dir) {
            f32x16_t acc[4];
#pragma unroll
            for (int nt = 0; nt < 4; ++nt)
#pragma unroll
                for (int i = 0; i < 16; ++i) acc[nt][i] = 0.f;
#pragma unroll
            for (int ks = 0; ks < 4; ++ks)
#pragma unroll
                for (int nt = 0; nt < 4; ++nt) {
                    const bf16x8_t bfr = *LDSP(bf16x8_t, GL_X + dir * (128 * GL_KS * 2) + ((nt * 32 + r) * GL_KS + ks * 16 + 8 * hh) * 2);
                    acc[nt] = __builtin_amdgcn_mfma_f32_32x32x16_bf16(va[ks], bfr, acc[nt], 0, 0, 0);
                }
            bf16_t* dst = ST + ((size_t)(dir ? chb : chf) * GL_NS + (dir ? it.sb : it.sf)) * 32768;
#pragma unroll
            for (int reg = 0; reg < 16; ++reg) {
                const int e = e0 + (reg & 3) + 8 * (reg >> 2) + 4 * hh;
                uint2 wq; wq.x = pack2(acc[0][reg], acc[1][reg]); wq.y = pack2(acc[2][reg], acc[3][reg]);
                *(uint2*)(dst + e * 128 + 4 * r) = wq;
            }
        }
        __syncthreads();
        if (has_next) gla_commit<false>(smem, R, bw, bg);
    }
}
#define PB_LOAD(L, D, S0) { _Pragma("unroll") for (int u = 0; u < 10; ++u) { L[u] = *(const uint2*)(base + (size_t)((S0) + u) * 32768); D[u] = *(const float4*)(dbase + (size_t)((S0) + u) * 128); } }
#define PB_PROC(L, D, S0) { _Pragma("unroll") for (int u = 0; u < 10; ++u) { uint2 o; o.x = pack2(s0, s1); o.y = pack2(s2, s3); if (DRY) { o.x = L[u].x + (o.x & 0u); o.y = L[u].y + (o.y & 0u); } *(uint2*)(base + (size_t)((S0) + u) * 32768) = o; \
        s0 = D[u].x * s0 + bflo(L[u].x); s1 = D[u].y * s1 + bfhi(L[u].x); s2 = D[u].z * s2 + bflo(L[u].y); s3 = D[u].w * s3 + bfhi(L[u].y); } }
template <bool DRY> __device__ void st_gla_passB(const Params& p, int bid, int nb) {
    bf16_t* ST = (bf16_t*)(p.ws + WS_ST);
    const float* DEC = (const float*)(p.ws + WS_DEC);
    for (int g = bid * NTHR + threadIdx.x; g < 16 * 8192; g += nb * NTHR) {
        const int chain = g >> 13, grp = g & 8191;
        bf16_t* base = ST + (size_t)chain * GL_NS * 32768 + grp * 4;
        const float* dbase = DEC + (size_t)chain * GL_NS * 128 + ((grp * 4) & 127);
        float s0 = 0.f, s1 = 0.f, s2 = 0.f, s3 = 0.f;
        uint2 La[10], Lb[10]; float4 Da[10], Db[10];
        PB_LOAD(La, Da, 0)
#pragma unroll 1
        for (int it = 0; it < 26; it += 2) {
            PB_LOAD(Lb, Db, (it + 1) * 10)
            PB_PROC(La, Da, it * 10)
            if (it + 2 < 26) PB_LOAD(La, Da, (it + 2) * 10)
            PB_PROC(Lb, Db, (it + 1) * 10)
        }
    }
}
__device__ void st_gla_passC(const Params& p, int bid, int nb, unsigned char* smem) {
    PG8_LAS unsigned char* lds3 = (PG8_LAS unsigned char*)smem;
    const int tid = threadIdx.x, lane = tid & 63, wv = __builtin_amdgcn_readfirstlane(tid >> 6);
    const bf16_t* ST = (const bf16_t*)(p.ws + WS_ST);
    const bf16_t* P = (const bf16_t*)(p.ws + WS_P);
    bf16_t* A = (bf16_t*)(p.ws + WS_A);
    GlaRaw R; uint4 bw = make_uint4(0u, 0u, 0u, 0u); float bg = 0.f;
    __syncthreads();
    if (bid < 2048) { const GlaItem it0 = gla_item(bid); gla_fetch<true>(p, R, it0.row0, it0.h); gla_commit<true>(smem, R, bw, bg); }
    for (int item = bid; item < 2048; item += nb) {
        const GlaItem it = gla_item(item);
        const int chf = it.b * 8 + it.h * 2, chb = chf + 1;
        const bool has_next = item + nb < 2048;
        __syncthreads();
        const int e0 = wv * 32, r = lane & 31, hh = lane >> 5;
        const bf16_t* sfp = ST + ((size_t)chf * GL_NS + it.sf) * 32768 + (size_t)(e0 + r) * 128 + 8 * hh;
        const bf16_t* sbp = ST + ((size_t)chb * GL_NS + it.sb) * 32768 + (size_t)(e0 + r) * 128 + 8 * hh;
        bf16x8_t saf[8], sab[8];
#pragma unroll
        for (int ks = 0; ks < 8; ++ks) { saf[ks] = *(const bf16x8_t*)(sfp + ks * 16); sab[ks] = *(const bf16x8_t*)(sbp + ks * 16); }
        if (has_next) { const GlaItem itn = gla_item(item + nb); gla_fetch<true>(p, R, itn.row0, itn.h); }
        __builtin_amdgcn_sched_barrier(0);
        gla_z(smem, bw, bg);
        __syncthreads();
        gla_prep<false>(smem, nullptr, nullptr);
        __syncthreads();
        {
            const int l15 = lane & 15, l4 = lane >> 4;
            unsigned bt = GL_X + (l15 * GL_XS + l4 * 8) * 2; asm volatile("" : "+v"(bt));
#pragma unroll
            for (int tt = 0; tt < 2; ++tt) {
                const int T = wv * 2 + tt, jt = T >> 2, itl = T & 3;
                const unsigned ba = bt + jt * (16 * GL_XS * 2), bq = bt + itl * (16 * GL_XS * 2);
                f32x4_t af = {0.f, 0.f, 0.f, 0.f}, ab = {0.f, 0.f, 0.f, 0.f};
                if (jt <= itl) {
#pragma unroll
                    for (int ks = 0; ks < 4; ++ks) {
                        const bf16x8_t a = *LDSP(bf16x8_t, ba + 1 * 64 * GL_XS * 2 + ks * 64);
                        const bf16x8_t bb = *LDSP(bf16x8_t, bq + 0 * 64 * GL_XS * 2 + ks * 64);
                        af = __builtin_amdgcn_mfma_f32_16x16x32_bf16(a, bb, af, 0, 0, 0);
                    }
                }
                if (jt >= itl) {
#pragma unroll
                    for (int ks = 0; ks < 4; ++ks) {
                        const bf16x8_t a = *LDSP(bf16x8_t, ba + 3 * 64 * GL_XS * 2 + ks * 64);
                        const bf16x8_t bb = *LDSP(bf16x8_t, bq + 2 * 64 * GL_XS * 2 + ks * 64);
                        ab = __builtin_amdgcn_mfma_f32_16x16x32_bf16(a, bb, ab, 0, 0, 0);
                    }
                }
                const int i = itl * 16 + l15;
                float pv[4];
#pragma unroll
                for (int reg = 0; reg < 4; ++reg) { const int j = jt * 16 + l4 * 4 + reg; pv[reg] = (j <= i ? af[reg] : 0.f) + (j >= i ? ab[reg] : 0.f); }
                uint2 wq; wq.x = pack2(pv[0], pv[1]); wq.y = pack2(pv[2], pv[3]);
                *(uint2*)(smem + GL_P + (i * GL_KS + jt * 16 + l4 * 4) * 2) = wq;
            }
        }
        __syncthreads();
        f32x16_t acc0, acc1;
#pragma unroll
        for (int i = 0; i < 16; ++i) { acc0[i] = 0.f; acc1[i] = 0.f; }
        {
            unsigned bp = GL_P + (r * GL_KS + 8 * hh) * 2; asm volatile("" : "+v"(bp));
#pragma unroll
            for (int ks = 0; ks < 4; ++ks) {
                const bf16x8_t a = gla_vt_frag(lds3, e0, ks, lane);
                const bf16x8_t b0 = *LDSP(bf16x8_t, bp + ks * 32);
                const bf16x8_t b1 = *LDSP(bf16x8_t, bp + 32 * GL_KS * 2 + ks * 32);
                acc0 = __builtin_amdgcn_mfma_f32_32x32x16_bf16(a, b0, acc0, 0, 0, 0);
                acc1 = __builtin_amdgcn_mfma_f32_32x32x16_bf16(a, b1, acc1, 0, 0, 0);
            }
            unsigned bx = GL_X + (r * GL_XS + 8 * hh) * 2; asm volatile("" : "+v"(bx));
#pragma unroll
            for (int ks = 0; ks < 8; ++ks) {
                const bf16x8_t b0 = *LDSP(bf16x8_t, bx + 0 * 64 * GL_XS * 2 + ks * 32);
                const bf16x8_t b1 = *LDSP(bf16x8_t, bx + 0 * 64 * GL_XS * 2 + 32 * GL_XS * 2 + ks * 32);
                acc0 = __builtin_amdgcn_mfma_f32_32x32x16_bf16(saf[ks], b0, acc0, 0, 0, 0);
                acc1 = __builtin_amdgcn_mfma_f32_32x32x16_bf16(saf[ks], b1, acc1, 0, 0, 0);
            }
#pragma unroll
            for (int ks = 0; ks < 8; ++ks) {
                const bf16x8_t b0 = *LDSP(bf16x8_t, bx + 2 * 64 * GL_XS * 2 + ks * 32);
                const bf16x8_t b1 = *LDSP(bf16x8_t, bx + 2 * 64 * GL_XS * 2 + 32 * GL_XS * 2 + ks * 32);
                acc0 = __builtin_amdgcn_mfma_f32_32x32x16_bf16(sab[ks], b0, acc0, 0, 0, 0);
                acc1 = __builtin_amdgcn_mfma_f32_32x32x16_bf16(sab[ks], b1, acc1, 0, 0, 0);
            }
        }
        __syncthreads();
        uint4 gbv[4]; float4 n0v[4], n1v[4];
        {
            const size_t rowg = it.row0 + (tid >> 3);
            const int cg0 = it.h * 256 + (tid & 7) * 32;
#pragma unroll
            for (int q = 0; q < 4; ++q) { gbv[q] = *(const uint4*)(P + rowg * NP + PC_G + cg0 + q * 8); n0v[q] = *(const float4*)(p.in[I_GNG] + cg0 + q * 8); n1v[q] = *(const float4*)(p.in[I_GNG] + cg0 + q * 8 + 4); }
        }
        __builtin_amdgcn_sched_barrier(0);
        if (has_next) gla_commit<true>(smem, R, bw, bg);
        {
            float* ob = (float*)(smem + GL_OBUF);
#pragma unroll
            for (int g4 = 0; g4 < 4; ++g4) {
                const int e = e0 + 8 * g4 + 4 * hh;
                float4 o0; o0.x = acc0[g4 * 4 + 0]; o0.y = acc0[g4 * 4 + 1]; o0.z = acc0[g4 * 4 + 2]; o0.w = acc0[g4 * 4 + 3];
                float4 o1; o1.x = acc1[g4 * 4 + 0]; o1.y = acc1[g4 * 4 + 1]; o1.z = acc1[g4 * 4 + 2]; o1.w = acc1[g4 * 4 + 3];
                *(float4*)(ob + (r) * 260 + e) = o0;
                *(float4*)(ob + (32 + r) * 260 + e) = o1;
            }
        }
        __syncthreads();
        {
            const float* ob = (const float*)(smem + GL_OBUF);
            int tid2 = tid; asm volatile("" : "+v"(tid2));
            const int i = tid2 >> 3, part = tid2 & 7;
            float o[32];
            float ss = 0.f;
#pragma unroll
            for (int q = 0; q < 8; ++q) { const float4 v = *(const float4*)(ob + i * 260 + part * 32 + q * 4); o[q * 4 + 0] = v.x; o[q * 4 + 1] = v.y; o[q * 4 + 2] = v.z; o[q * 4 + 3] = v.w; ss += v.x * v.x + v.y * v.y + v.z * v.z + v.w * v.w; }
            ss += __shfl_xor(ss, 1); ss += __shfl_xor(ss, 2); ss += __shfl_xor(ss, 4);
            const float rs = rsqrtf(ss * (1.0f / 256.0f) + EPS);
            const size_t row = it.row0 + i;
            const int c0 = it.h * 256 + part * 32;
#pragma unroll
            for (int q = 0; q < 4; ++q) {
                const uint4 gb = gbv[q];
                const float4 n0 = n0v[q], n1 = n1v[q];
                uint4 wq;
                wq.x = pack2(o[q * 8 + 0] * rs * n0.x * silu_f(bflo(gb.x)), o[q * 8 + 1] * rs * n0.y * silu_f(bfhi(gb.x)));
                wq.y = pack2(o[q * 8 + 2] * rs * n0.z * silu_f(bflo(gb.y)), o[q * 8 + 3] * rs * n0.w * silu_f(bfhi(gb.y)));
                wq.z = pack2(o[q * 8 + 4] * rs * n1.x * silu_f(bflo(gb.z)), o[q * 8 + 5] * rs * n1.y * silu_f(bfhi(gb.z)));
                wq.w = pack2(o[q * 8 + 6] * rs * n1.z * silu_f(bflo(gb.w)), o[q * 8 + 7] * rs * n1.w * silu_f(bfhi(gb.w)));
                *(uint4*)(A + row * DM + c0 + q * 8) = wq;
            }
        }
    }
}

__device__ void st_cmlp_naive(const Params& p, int bid, int nb, float* lds) {
    const int tid = threadIdx.x, lane = tid & 63, wv = tid >> 6;
    const bf16_t* P = (const bf16_t*)(p.ws + WS_P);
    bf16_t* A = (bf16_t*)(p.ws + WS_A);
    float* sWT = lds; float* sV = lds + 16384; float* smu = lds + 32768; float* srs = lds + 32768 + 128;
    for (int chunk = bid; chunk < 256; chunk += nb) {
        const int r0 = chunk * 128;
        __syncthreads();
        for (int tt = 0; tt < 16; ++tt) {
            const int q = wv * 16 + tt;
            const bf16_t* pr = P + (size_t)(r0 + q) * NP + PC_V2;
            const uint4 a = *(const uint4*)(pr + lane * 8), b2 = *(const uint4*)(pr + 512 + lane * 8);
            float v[16];
            v[0] = bflo(a.x); v[1] = bfhi(a.x); v[2] = bflo(a.y); v[3] = bfhi(a.y); v[4] = bflo(a.z); v[5] = bfhi(a.z); v[6] = bflo(a.w); v[7] = bfhi(a.w);
            v[8] = bflo(b2.x); v[9] = bfhi(b2.x); v[10] = bflo(b2.y); v[11] = bfhi(b2.y); v[12] = bflo(b2.z); v[13] = bfhi(b2.z); v[14] = bflo(b2.w); v[15] = bfhi(b2.w);
            float s = 0.f;
#pragma unroll
            for (int j = 0; j < 16; ++j) s += v[j];
            s = wave_sum(s);
            const float mu = s * (1.0f / 1024.0f);
            float ss = 0.f;
#pragma unroll
            for (int j = 0; j < 16; ++j) { const float d = v[j] - mu; ss += d * d; }
            ss = wave_sum(ss);
            if (lane == 0) { smu[q] = mu; srs[q] = rsqrtf(ss * (1.0f / 1024.0f) + EPS); }
        }
        __syncthreads();
        for (int g = 0; g < 8; ++g) {
            {
                const float* Wg = p.in[I_WS] + (size_t)g * 16384;
                const int pl = tid & 127, qq = tid >> 7;
#pragma unroll
                for (int it = 0; it < 8; ++it) {
                    const int q4 = qq + 4 * it;
                    const float4 w = *(const float4*)(Wg + pl * 128 + q4 * 4);
                    sWT[(q4 * 4 + 0) * 128 + pl] = w.x; sWT[(q4 * 4 + 1) * 128 + pl] = w.y; sWT[(q4 * 4 + 2) * 128 + pl] = w.z; sWT[(q4 * 4 + 3) * 128 + pl] = w.w;
                }
            }
            {
                const int q = tid >> 2, cs = tid & 3;
                const float mu = smu[q], rs = srs[q];
                const bf16_t* pr = P + (size_t)(r0 + q) * NP + PC_V2 + g * 128 + cs * 32;
#pragma unroll
                for (int i = 0; i < 4; ++i) {
                    const uint4 a = *(const uint4*)(pr + i * 8);
                    const int c = g * 128 + cs * 32 + i * 8;
                    const float4 lg0 = *(const float4*)(p.in[I_LNG] + c), lg1 = *(const float4*)(p.in[I_LNG] + c + 4);
                    const float4 lb0 = *(const float4*)(p.in[I_LNB] + c), lb1 = *(const float4*)(p.in[I_LNB] + c + 4);
                    float* d = sV + q * 128 + cs * 32 + i * 8;
                    d[0] = (bflo(a.x) - mu) * rs * lg0.x + lb0.x; d[1] = (bfhi(a.x) - mu) * rs * lg0.y + lb0.y;
                    d[2] = (bflo(a.y) - mu) * rs * lg0.z + lb0.z; d[3] = (bfhi(a.y) - mu) * rs * lg0.w + lb0.w;
                    d[4] = (bflo(a.z) - mu) * rs * lg1.x + lb1.x; d[5] = (bfhi(a.z) - mu) * rs * lg1.y + lb1.y;
                    d[6] = (bflo(a.w) - mu) * rs * lg1.z + lb1.z; d[7] = (bfhi(a.w) - mu) * rs * lg1.w + lb1.w;
                }
            }
            __syncthreads();
            const int pg = tid >> 4, cgi = tid & 15;
            float acc[4][8];
#pragma unroll
            for (int i = 0; i < 4; ++i)
#pragma unroll
                for (int j = 0; j < 8; ++j) acc[i][j] = 0.f;
#pragma unroll 4
            for (int q = 0; q < 128; ++q) {
                const float4 w = *(const float4*)(sWT + q * 128 + pg * 4);
                const float4 v0 = *(const float4*)(sV + q * 128 + cgi * 8), v1 = *(const float4*)(sV + q * 128 + cgi * 8 + 4);
                const float wv4[4] = {w.x, w.y, w.z, w.w};
                const float vv[8] = {v0.x, v0.y, v0.z, v0.w, v1.x, v1.y, v1.z, v1.w};
#pragma unroll
                for (int i = 0; i < 4; ++i)
#pragma unroll
                    for (int j = 0; j < 8; ++j) acc[i][j] += wv4[i] * vv[j];
            }
#pragma unroll
            for (int i = 0; i < 4; ++i) {
                const int pp = pg * 4 + i; const size_t row = (size_t)(r0 + pp);
                const float bs = p.in[I_BS][g * 128 + pp];
                const uint4 u8 = *(const uint4*)(P + row * NP + PC_U + g * 128 + cgi * 8);
                uint4 w;
                w.x = pack2(bflo(u8.x) * (acc[i][0] + bs), bfhi(u8.x) * (acc[i][1] + bs));
                w.y = pack2(bflo(u8.y) * (acc[i][2] + bs), bfhi(u8.y) * (acc[i][3] + bs));
                w.z = pack2(bflo(u8.z) * (acc[i][4] + bs), bfhi(u8.z) * (acc[i][5] + bs));
                w.w = pack2(bflo(u8.w) * (acc[i][6] + bs), bfhi(u8.w) * (acc[i][7] + bs));
                *(uint4*)(A + row * DM + 1024 + g * 128 + cgi * 8) = w;
            }
            __syncthreads();
        }
    }
}

__device__ __forceinline__ unsigned fkey(float f) { const unsigned u = __float_as_uint(f); return (u & 0x80000000u) ? ~u : (u | 0x80000000u); }
template <int NV>
__device__ __forceinline__ void select16(const float (&val)[NV], const int (&id)[NV], float* ov, int* oi, int lane) {
    unsigned key[NV];
#pragma unroll
    for (int v = 0; v < NV; ++v) key[v] = fkey(val[v]);
    unsigned prefix = 0u;
    for (int bit = 31; bit >= 0; --bit) {
        const unsigned cand = prefix | (1u << bit);
        int cnt = 0;
#pragma unroll
        for (int v = 0; v < NV; ++v) cnt += __popcll(__ballot(key[v] >= cand));
        if (cnt >= 16) prefix = cand;
    }
    unsigned long long mgt[NV], meq[NV]; int ngt = 0;
#pragma unroll
    for (int v = 0; v < NV; ++v) { mgt[v] = __ballot(key[v] > prefix); meq[v] = __ballot(key[v] == prefix); ngt += __popcll(mgt[v]); }
    const int need = 16 - ngt;
    const unsigned long long lt = (1ull << lane) - 1ull;
    int base = 0, ebase = 0;
#pragma unroll
    for (int v = 0; v < NV; ++v) {
        if (key[v] > prefix) { const int pos = base + __popcll(mgt[v] & lt); ov[pos] = val[v]; oi[pos] = id[v]; }
        else if (key[v] == prefix) { const int er = ebase + __popcll(meq[v] & lt); if (er < need) { ov[ngt + er] = val[v]; oi[ngt + er] = id[v]; } }
        base += __popcll(mgt[v]); ebase += __popcll(meq[v]);
    }
}
__device__ void st_topk_naive(const Params& p, int bid, int nb, float* lds) {
    const int tid = threadIdx.x, lane = tid & 63, wv = __builtin_amdgcn_readfirstlane(tid >> 6);
    const float* Q = (const float*)(p.ws + WS_Q);
    int* IDX = (int*)(p.ws + WS_IDX); float* GATE = (float*)(p.ws + WS_GATE);
    float* sK = lds;
    float* wq = lds + 33792 + wv * 384;
    float* v1 = wq + 256; int* i1 = (int*)(wq + 272); float* v2 = wq + 288; int* i2 = (int*)(wq + 304); float* bv = wq + 320; int* be = (int*)(wq + 336);
    for (int item = bid; item < 256; item += nb) {
        const int h = item & 7, tr = item >> 3;
        __syncthreads();
        for (int i = tid; i < 2 * 128 * 32; i += NTHR) {
            const int hf = i >> 12, k = (i >> 5) & 127, d4 = i & 31;
            const float4 w = *(const float4*)(p.in[I_SK] + ((size_t)(hf * 8 + h) * 128 + k) * 128 + d4 * 4);
            *(float4*)(sK + (hf * 128 + k) * 132 + d4 * 4) = w;
        }
        __syncthreads();
        for (int tt = wv; tt < 1024; tt += 8) {
            const int t = tr * 1024 + tt;
            wave_lds_fence();
            *(float4*)(wq + lane * 4) = *(const float4*)(Q + (size_t)t * DM + h * 256 + lane * 4);
            wave_lds_fence();
            float s[2][2] = {{0.f, 0.f}, {0.f, 0.f}};
#pragma unroll
            for (int hf = 0; hf < 2; ++hf)
#pragma unroll 8
                for (int d4 = 0; d4 < 32; ++d4) {
                    const float4 qq = *(const float4*)(wq + hf * 128 + d4 * 4);
#pragma unroll
                    for (int kk = 0; kk < 2; ++kk) {
                        const float4 kv = *(const float4*)(sK + (hf * 128 + lane + 64 * kk) * 132 + d4 * 4);
                        s[hf][kk] += qq.x * kv.x + qq.y * kv.y + qq.z * kv.z + qq.w * kv.w;
                    }
                }
            const int ids[2] = {lane, lane + 64};
            select16<2>(s[0], ids, v1, i1, lane);
            select16<2>(s[1], ids, v2, i2, lane);
            wave_lds_fence();
            float cand[4]; int cid[4];
            {
                const int a = lane >> 2, b0 = (lane & 3) * 4;
                const float va = v1[a]; const int ia = i1[a];
#pragma unroll
                for (int j = 0; j < 4; ++j) { cand[j] = va + v2[b0 + j]; cid[j] = ia * 128 + i2[b0 + j]; }
            }
            select16<4>(cand, cid, bv, be, lane);
            wave_lds_fence();
            const float x = lane < 16 ? bv[lane] : -3.0e38f;
            const float mx = wave_max(x);
            const float ex = lane < 16 ? expf(x - mx) : 0.f;
            const float sm = wave_sum(ex);
            if (lane < 16) { IDX[(size_t)t * 128 + h * 16 + lane] = be[lane]; GATE[(size_t)t * 128 + h * 16 + lane] = ex / sm; }
        }
    }
}

constexpr int CM_VS = 160;
constexpr int CM_TILE = 128 * CM_VS * 2;
constexpr int CM_MU = 2 * CM_TILE, CM_RS = CM_MU + 512;
__device__ void st_cmlp_mfma(const Params& p, int bid, int nb, unsigned char* smem) {
    PG8_LAS unsigned char* lds3 = (PG8_LAS unsigned char*)smem;
    const int tid = threadIdx.x, lane = tid & 63, wv = __builtin_amdgcn_readfirstlane(tid >> 6);
    const bf16_t* P = (const bf16_t*)(p.ws + WS_P);
    bf16_t* A = (bf16_t*)(p.ws + WS_A);
    float* smu = (float*)(smem + CM_MU); float* srs = (float*)(smem + CM_RS);
    for (int chunk = bid; chunk < 256; chunk += nb) {
        const int r0 = chunk * 128;
        __syncthreads();
        for (int tt = 0; tt < 16; ++tt) {
            const int q = wv * 16 + tt;
            const bf16_t* pr = P + (size_t)(r0 + q) * NP + PC_V2;
            const uint4 a = *(const uint4*)(pr + lane * 8), b2 = *(const uint4*)(pr + 512 + lane * 8);
            float v[16];
            v[0] = bflo(a.x); v[1] = bfhi(a.x); v[2] = bflo(a.y); v[3] = bfhi(a.y); v[4] = bflo(a.z); v[5] = bfhi(a.z); v[6] = bflo(a.w); v[7] = bfhi(a.w);
            v[8] = bflo(b2.x); v[9] = bfhi(b2.x); v[10] = bflo(b2.y); v[11] = bfhi(b2.y); v[12] = bflo(b2.z); v[13] = bfhi(b2.z); v[14] = bflo(b2.w); v[15] = bfhi(b2.w);
            float sm = 0.f;
#pragma unroll
            for (int j = 0; j < 16; ++j) sm += v[j];
            sm = wave_sum(sm);
            const float mu = sm * (1.0f / 1024.0f);
            float ss = 0.f;
#pragma unroll
            for (int j = 0; j < 16; ++j) { const float d = v[j] - mu; ss += d * d; }
            ss = wave_sum(ss);
            if (lane == 0) { smu[q] = mu; srs[q] = rsqrtf(ss * (1.0f / 1024.0f) + EPS); }
        }
        __syncthreads();
        for (int gp = 0; gp < 4; ++gp) {
            {
                const int gsel = tid >> 8, q = (tid >> 1) & 127, half = tid & 1;
                const int g = gp * 2 + gsel;
                const float mu = smu[q], rs = srs[q];
                const bf16_t* pr = P + (size_t)(r0 + q) * NP + PC_V2 + g * 128 + half * 64;
                unsigned char* img = smem + gsel * CM_TILE + q * (CM_VS * 2);
#pragma unroll
                for (int i = 0; i < 8; ++i) {
                    const uint4 a = *(const uint4*)(pr + i * 8);
                    const int c = g * 128 + half * 64 + i * 8;
                    const float4 lg0 = *(const float4*)(p.in[I_LNG] + c), lg1 = *(const float4*)(p.in[I_LNG] + c + 4);
                    const float4 lb0 = *(const float4*)(p.in[I_LNB] + c), lb1 = *(const float4*)(p.in[I_LNB] + c + 4);
                    const float n0 = (bflo(a.x) - mu) * rs * lg0.x + lb0.x, n1 = (bfhi(a.x) - mu) * rs * lg0.y + lb0.y;
                    const float n2 = (bflo(a.y) - mu) * rs * lg0.z + lb0.z, n3 = (bfhi(a.y) - mu) * rs * lg0.w + lb0.w;
                    const float n4 = (bflo(a.z) - mu) * rs * lg1.x + lb1.x, n5 = (bfhi(a.z) - mu) * rs * lg1.y + lb1.y;
                    const float n6 = (bflo(a.w) - mu) * rs * lg1.z + lb1.z, n7 = (bfhi(a.w) - mu) * rs * lg1.w + lb1.w;
                    const int cq = (half * 64 + i * 8) >> 2;
                    *(unsigned*)(img + (0 * 32 + cq) * 2) = pack2(n0, n4);
                    *(unsigned*)(img + (1 * 32 + cq) * 2) = pack2(n1, n5);
                    *(unsigned*)(img + (2 * 32 + cq) * 2) = pack2(n2, n6);
                    *(unsigned*)(img + (3 * 32 + cq) * 2) = pack2(n3, n7);
                }
            }
            __syncthreads();
            {
                const int g = gp * 2 + (wv >> 2), mt = wv & 3;
                const int r = lane & 31, hh = lane >> 5;
                const float* wrow = p.in[I_WS] + ((size_t)g * 128 + mt * 32 + r) * 128 + 8 * hh;
                f32x16_t acc[4];
#pragma unroll
                for (int nt = 0; nt < 4; ++nt)
#pragma unroll
                    for (int i = 0; i < 16; ++i) acc[nt][i] = 0.f;
                const int grp = lane >> 4, li = lane & 15, qq = li >> 2, pp = li & 3;
                unsigned bv = (wv >> 2) * CM_TILE + ((8 * (grp >> 1) + qq) * CM_VS + 16 * (grp & 1) + 4 * pp) * 2; asm volatile("" : "+v"(bv));
#pragma unroll
                for (int ks = 0; ks < 8; ++ks) {
                    const float4 wa = *(const float4*)(wrow + ks * 16), wb = *(const float4*)(wrow + ks * 16 + 4);
                    uint4 aw; aw.x = pack2(wa.x, wa.y); aw.y = pack2(wa.z, wa.w); aw.z = pack2(wb.x, wb.y); aw.w = pack2(wb.z, wb.w);
                    const bf16x8_t af = __builtin_bit_cast(bf16x8_t, aw);
#pragma unroll
                    for (int nt = 0; nt < 4; ++nt) {
                        const s16x4_t lo = __builtin_amdgcn_ds_read_tr16_b64_v4i16(LDSP(s16x4_t, bv + ks * (16 * CM_VS * 2) + nt * 64));
                        const s16x4_t hi = __builtin_amdgcn_ds_read_tr16_b64_v4i16(LDSP(s16x4_t, bv + ks * (16 * CM_VS * 2) + 4 * CM_VS * 2 + nt * 64));
                        const bf16x8_t bfr = __builtin_shufflevector(lo, hi, 0, 1, 2, 3, 4, 5, 6, 7);
                        acc[nt] = __builtin_amdgcn_mfma_f32_32x32x16_bf16(af, bfr, acc[nt], 0, 0, 0);
                    }
                }
#pragma unroll
                for (int reg = 0; reg < 16; ++reg) {
                    const int pp2 = mt * 32 + (reg & 3) + 8 * (reg >> 2) + 4 * hh; const size_t row = (size_t)(r0 + pp2);
                    const float bs = p.in[I_BS][g * 128 + pp2];
                    const uint2 u4 = *(const uint2*)(P + row * NP + PC_U + g * 128 + 4 * r);
                    uint2 w;
                    w.x = pack2(bflo(u4.x) * (acc[0][reg] + bs), bfhi(u4.x) * (acc[1][reg] + bs));
                    w.y = pack2(bflo(u4.y) * (acc[2][reg] + bs), bfhi(u4.y) * (acc[3][reg] + bs));
                    *(uint2*)(A + row * DM + 1024 + g * 128 + 4 * r) = w;
                }
            }
            __syncthreads();
        }
    }
}

constexpr int TK_KS = 136;
constexpr int TK_KEYS = 0;
constexpr int TK_TAB = 139264;
constexpr int TK_SCR = 139328;
__device__ __forceinline__ unsigned tk_ord(float f) { const unsigned u = __float_as_uint(f); return u ^ ((unsigned)((int)u >> 31) | 0x80000000u); }
__device__ __forceinline__ float tk_unord(unsigned k) { return __uint_as_float((k & 0x80000000u) ? (k ^ 0x80000000u) : ~k); }
#define TK_CE(a, b) { const unsigned mx_ = max(a, b), mn_ = min(a, b); a = mx_; b = mn_; }
template <int N> __device__ __forceinline__ void tk_sort16(unsigned (&k)[N], const int base) {
#pragma unroll
    for (int size = 2; size <= 16; size *= 2)
#pragma unroll
        for (int stride = size / 2; stride >= 1; stride /= 2)
#pragma unroll
            for (int i = 0; i < 16; ++i) {
                const int j = i ^ stride;
                if (j > i) { if ((i & size) == 0 || size == 16) { TK_CE(k[base + i], k[base + j]) } else { TK_CE(k[base + j], k[base + i]) } }
            }
}
template <int N> __device__ __forceinline__ void tk_merge16(unsigned (&k)[N], const int a0, const int b0) {
#pragma unroll
    for (int i = 0; i < 16; ++i) k[a0 + i] = max(k[a0 + i], k[b0 + 15 - i]);
#pragma unroll
    for (int stride = 8; stride >= 1; stride /= 2)
#pragma unroll
        for (int i = 0; i < 16; ++i) { const int j = i ^ stride; if (j > i) { TK_CE(k[a0 + i], k[a0 + j]) } }
}
__device__ void st_topk_mfma(const Params& p, int bid, int nb, unsigned char* smem) {
    PG8_LAS unsigned char* lds3 = (PG8_LAS unsigned char*)smem;
    const int tid = threadIdx.x, lane = tid & 63, wv = __builtin_amdgcn_readfirstlane(tid >> 6);
    const bf16_t* Q = (const bf16_t*)(p.ws + WS_Q);
    int* IDX = (int*)(p.ws + WS_IDX); float* GATE = (float*)(p.ws + WS_GATE);
    const int r = lane & 31, hh = lane >> 5;
    for (int item = bid; item < 256; item += nb) {
        const int h = item & 7, tr = item >> 3;
        __syncthreads();
        for (int i = tid; i < 2 * 128 * 32; i += NTHR) {
            const int hf = i >> 12, k = (i >> 5) & 127, d4 = i & 31;
            const float4 w = *(const float4*)(p.in[I_SK] + ((size_t)(hf * 8 + h) * 128 + k) * 128 + d4 * 4);
            const unsigned short h0 = f2bf(w.x), h1 = f2bf(w.y), h2 = f2bf(w.z), h3 = f2bf(w.w);
            uint2 hi2, lo2;
            hi2.x = (unsigned)h0 | ((unsigned)h1 << 16); hi2.y = (unsigned)h2 | ((unsigned)h3 << 16);
            lo2.x = pack2(w.x - bf2f(h0), w.y - bf2f(h1)); lo2.y = pack2(w.z - bf2f(h2), w.w - bf2f(h3));
            *(uint2*)(smem + TK_KEYS + (((hf * 2 + 0) * 128 + k) * TK_KS + d4 * 4) * 2) = hi2;
            *(uint2*)(smem + TK_KEYS + (((hf * 2 + 1) * 128 + k) * TK_KS + d4 * 4) * 2) = lo2;
        }
        if (tid < 64) {
            int c = 0, val = 0;
            for (int a = 0; a < 16; ++a) for (int b = 0; b < 16 / (a + 1); ++b) { if (c == tid) val = a * 16 + b; ++c; }
            smem[TK_TAB + tid] = (unsigned char)val;
        }
        __syncthreads();
        for (int u = wv; u < 32; u += 8) {
            const int t0 = tr * 1024 + u * 32;
            const bf16_t* qrow = Q + (size_t)(t0 + r) * DM + h * 256 + 8 * hh;
            unsigned ka = TK_KEYS + (r * TK_KS + 8 * hh) * 2; asm volatile("" : "+v"(ka));
            f32x16_t acc[2][4];
            uint4 qraw[2][8];
#pragma unroll
            for (int hf = 0; hf < 2; ++hf)
#pragma unroll
                for (int ks = 0; ks < 8; ++ks) qraw[hf][ks] = *(const uint4*)(qrow + hf * 128 + ks * 16);
#pragma unroll
            for (int hf = 0; hf < 2; ++hf)
#pragma unroll
                for (int ks = 0; ks < 8; ks += 2)
                    asm volatile("" : "+v"(qraw[hf][ks].x), "+v"(qraw[hf][ks].y), "+v"(qraw[hf][ks].z), "+v"(qraw[hf][ks].w), "+v"(qraw[hf][ks + 1].x), "+v"(qraw[hf][ks + 1].y), "+v"(qraw[hf][ks + 1].z), "+v"(qraw[hf][ks + 1].w));
#pragma unroll
            for (int hf = 0; hf < 2; ++hf) {
#pragma unroll
                for (int mt = 0; mt < 4; ++mt)
#pragma unroll
                    for (int i = 0; i < 16; ++i) acc[hf][mt][i] = 0.f;
#pragma unroll
                for (int ks = 0; ks < 8; ++ks) {
                    const bf16x8_t bq = __builtin_bit_cast(bf16x8_t, qraw[hf][ks]);
#pragma unroll
                    for (int mt = 0; mt < 4; ++mt) {
                        const bf16x8_t ah = *LDSP(bf16x8_t, ka + ((hf * 2 + 0) * 128 + mt * 32) * TK_KS * 2 + ks * 32);
                        const bf16x8_t al = *LDSP(bf16x8_t, ka + ((hf * 2 + 1) * 128 + mt * 32) * TK_KS * 2 + ks * 32);
                        acc[hf][mt] = __builtin_amdgcn_mfma_f32_32x32x16_bf16(ah, bq, acc[hf][mt], 0, 0, 0);
                        acc[hf][mt] = __builtin_amdgcn_mfma_f32_32x32x16_bf16(al, bq, acc[hf][mt], 0, 0, 0);
                    }
                }
            }
            unsigned k[128];
#pragma unroll
            for (int mt = 0; mt < 4; ++mt)
#pragma unroll
                for (int reg = 0; reg < 16; ++reg) {
                    const auto sw = __builtin_amdgcn_permlane32_swap(__float_as_uint(acc[0][mt][reg]), __float_as_uint(acc[1][mt][reg]), false, false);
                    const int kidx = 32 * mt + (reg & 3) + 8 * (reg >> 2);
                    k[mt * 32 + reg] = (tk_ord(__uint_as_float(sw[0])) & 0xFFFFFF80u) | (unsigned)kidx;
                    k[mt * 32 + 16 + reg] = (tk_ord(__uint_as_float(sw[1])) & 0xFFFFFF80u) | (unsigned)(kidx + 4);
                }
#pragma unroll
            for (int g = 0; g < 8; ++g) tk_sort16(k, g * 16);
            tk_merge16(k, 0, 16); tk_merge16(k, 32, 48); tk_merge16(k, 64, 80); tk_merge16(k, 96, 112);
            tk_merge16(k, 0, 32); tk_merge16(k, 64, 96);
            tk_merge16(k, 0, 64);
            unsigned X[16], Y[16];
#pragma unroll
            for (int j = 0; j < 16; ++j) { const auto sw = __builtin_amdgcn_permlane32_swap(k[j], k[j], false, false); X[j] = sw[0]; Y[j] = sw[1]; }
            {
                uint4 w0, w1;
                w0.x = (X[0] & 127u) | ((X[1] & 127u) << 8) | ((X[2] & 127u) << 16) | ((X[3] & 127u) << 24);
                w0.y = (X[4] & 127u) | ((X[5] & 127u) << 8) | ((X[6] & 127u) << 16) | ((X[7] & 127u) << 24);
                w0.z = (X[8] & 127u) | ((X[9] & 127u) << 8) | ((X[10] & 127u) << 16) | ((X[11] & 127u) << 24);
                w0.w = (X[12] & 127u) | ((X[13] & 127u) << 8) | ((X[14] & 127u) << 16) | ((X[15] & 127u) << 24);
                w1.x = (Y[0] & 127u) | ((Y[1] & 127u) << 8) | ((Y[2] & 127u) << 16) | ((Y[3] & 127u) << 24);
                w1.y = (Y[4] & 127u) | ((Y[5] & 127u) << 8) | ((Y[6] & 127u) << 16) | ((Y[7] & 127u) << 24);
                w1.z = (Y[8] & 127u) | ((Y[9] & 127u) << 8) | ((Y[10] & 127u) << 16) | ((Y[11] & 127u) << 24);
                w1.w = (Y[12] & 127u) | ((Y[13] & 127u) << 8) | ((Y[14] & 127u) << 16) | ((Y[15] & 127u) << 24);
                *(uint4*)(smem + TK_SCR + tid * 32) = w0; *(uint4*)(smem + TK_SCR + tid * 32 + 16) = w1;
            }
            float f1[16], f2[16];
#pragma unroll
            for (int j = 0; j < 16; ++j) { f1[j] = tk_unord((X[j] & 0xFFFFFF80u) | 64u); f2[j] = tk_unord((Y[j] & 0xFFFFFF80u) | 64u); }
            unsigned ck[64];
            {
                int c = 0;
#pragma unroll
                for (int a = 0; a < 16; ++a)
#pragma unroll
                    for (int b = 0; b < 16; ++b) if (b < 16 / (a + 1)) { ck[c] = (tk_ord(f1[a] + f2[b]) & 0xFFFFFFC0u) | (unsigned)c; ++c; }
#pragma unroll
                for (int cc = 50; cc < 64; ++cc) ck[cc] = 0u;
            }
            tk_sort16(ck, 0); tk_sort16(ck, 16); tk_sort16(ck, 32); tk_sort16(ck, 48);
            tk_merge16(ck, 0, 16); tk_merge16(ck, 32, 48); tk_merge16(ck, 0, 32);
            wave_lds_fence();
            float val[16]; int eidx[16];
#pragma unroll
            for (int j = 0; j < 16; ++j) {
                const unsigned ab = smem[TK_TAB + (ck[j] & 63u)];
                const unsigned e1 = smem[TK_SCR + tid * 32 + (ab >> 4)], e2 = smem[TK_SCR + tid * 32 + 16 + (ab & 15u)];
                eidx[j] = (int)(e1 * 128u + e2);
                val[j] = tk_unord((ck[j] & 0xFFFFFFC0u) | 32u);
            }
            float sm = 0.f;
#pragma unroll
            for (int j = 15; j >= 0; --j) val[j] = __expf(val[j] - val[0]);
#pragma unroll
            for (int j = 0; j < 16; ++j) sm += val[j];
            const float inv = 1.0f / sm;
            if (hh == 0) {
                int* ip = IDX + (size_t)(t0 + r) * 128 + h * 16; float* gp = GATE + (size_t)(t0 + r) * 128 + h * 16;
#pragma unroll
                for (int q4 = 0; q4 < 4; ++q4) {
                    int4 iv; iv.x = eidx[q4 * 4 + 0]; iv.y = eidx[q4 * 4 + 1]; iv.z = eidx[q4 * 4 + 2]; iv.w = eidx[q4 * 4 + 3];
                    float4 gv; gv.x = val[q4 * 4 + 0] * inv; gv.y = val[q4 * 4 + 1] * inv; gv.z = val[q4 * 4 + 2] * inv; gv.w = val[q4 * 4 + 3] * inv;
                    *(int4*)(ip + q4 * 4) = iv; *(float4*)(gp + q4 * 4) = gv;
                }
            }
            wave_lds_fence();
        }
    }
}

#define G_RED_STEP(OFF, N) { const bool hi_ = (lane & OFF) != 0; _Pragma("unroll") for (int i_ = 0; i_ < N; ++i_) { const float send_ = hi_ ? part[i_] : part[i_ + N]; const float keep_ = hi_ ? part[i_ + N] : part[i_]; part[i_] = keep_ + __shfl_xor(send_, OFF); } }
typedef unsigned u32x2sw_t __attribute__((ext_vector_type(2)));
__device__ __forceinline__ float g_swap32_add(float x, float y) { const u32x2sw_t r = __builtin_amdgcn_permlane32_swap(__float_as_uint(x), __float_as_uint(y), false, false); const unsigned a0 = r.x, a1 = r.y; return __uint_as_float(a0) + __uint_as_float(a1); }
__device__ __forceinline__ float g_swap16_add(float x, float y) { const u32x2sw_t r = __builtin_amdgcn_permlane16_swap(__float_as_uint(x), __float_as_uint(y), false, false); const unsigned a0 = r.x, a1 = r.y; return __uint_as_float(a0) + __uint_as_float(a1); }
template <int CTRL> __device__ __forceinline__ float g_dpp(float s) { return __int_as_float(__builtin_amdgcn_update_dpp(0, __float_as_int(s), CTRL, 0xf, 0xf, true)); }
__device__ void st_gather(const Params& p, int bid, int nb, unsigned char* smem) {
    const int wv = __builtin_amdgcn_readfirstlane(threadIdx.x >> 6);
    float* gvl = (float*)smem;
    for (int i = threadIdx.x; i < 2 * DM; i += NTHR) {
        const int b = i >> 11, k = i & (DM - 1);
        const float* mpb = (const float*)(p.ws + WS_M) + (size_t)b * 12288;
        gvl[b * (2 * DM) + k] = p.in[I_N2G][k] * (1.0f + mpb[4 * DM + k]);
        gvl[b * (2 * DM) + DM + k] = mpb[3 * DM + k];
        gvl[4 * DM + b * DM + k] = mpb[5 * DM + k];
        if (b == 0) gvl[6 * DM + k] = p.in[I_FNG][k];
    }
    __syncthreads();
    const bf16_t* H1b = (const bf16_t*)(p.ws + WS_H1);
    const float* SSQ = (const float*)(p.ws + WS_SSQ);
    const unsigned char* EU = p.ws + WS_EU;
    const unsigned char* EV = p.ws + WS_EV;
    const unsigned char* EU4 = p.ws + WS_EU4;
    const unsigned char* EV4 = p.ws + WS_EV4;
    const float* ESC = (const float*)(p.ws + WS_ESC);
    const int* IDX = (const int*)(p.ws + WS_IDX); const float* GATE = (const float*)(p.ws + WS_GATE);
    int ci0 = 0, ci1 = 0; float cg0 = 0.f, cg1 = 0.f, csq = 0.f, csu0 = 0.f, csu1 = 0.f, csv0 = 0.f, csv1 = 0.f; uint4 ch[4];
    {
        const int t0 = bid * 8 + wv;
        const int lane0 = threadIdx.x & 63;
#pragma unroll
        for (int q = 0; q < 4; ++q) ch[q] = make_uint4(0u, 0u, 0u, 0u);
        if (t0 < TLAT) {
            ci0 = IDX[(size_t)t0 * 128 + lane0]; ci1 = IDX[(size_t)t0 * 128 + 64 + lane0]; cg0 = GATE[(size_t)t0 * 128 + lane0]; cg1 = GATE[(size_t)t0 * 128 + 64 + lane0];
            csq = lane0 < 32 ? SSQ[(size_t)t0 * 32 + lane0] : 0.f;
#pragma unroll
            for (int q = 0; q < 4; ++q) ch[q] = *(const uint4*)(H1b + (size_t)t0 * DM + lane0 * 32 + q * 8);
            const int scs0 = ((lane0 & 15) < PEER_NHI) ? 0 : 2 * 16384;
            csu0 = ESC[scs0 + ci0]; csu1 = ESC[scs0 + ci1]; csv0 = ESC[scs0 + 16384 + ci0]; csv1 = ESC[scs0 + 16384 + ci1];
        }
    }
    for (int t = bid * 8 + wv; t < TLAT; t += nb * 8) {
        int lane = (int)__builtin_amdgcn_mbcnt_hi(~0u, __builtin_amdgcn_mbcnt_lo(~0u, 0u)); asm volatile("" : "+v"(lane));
        const int tn = t + nb * 8; const bool has_next = tn < TLAT;
        float xn[32];
        {
            const float rstd = rsqrtf(wave_sum(csq) * (1.0f / DM) + EPS);
            const PG8_LAS float* gsl = (const PG8_LAS float*)gvl + (t >> 14) * (2 * DM) + lane * 32;
#pragma unroll
            for (int q = 0; q < 4; ++q) {
                const uint4 a = ch[q];
                const f32x4_t g0 = *(const PG8_LAS f32x4_t*)(gsl + q * 8), g1 = *(const PG8_LAS f32x4_t*)(gsl + q * 8 + 4), s0 = *(const PG8_LAS f32x4_t*)(gsl + DM + q * 8), s1 = *(const PG8_LAS f32x4_t*)(gsl + DM + q * 8 + 4);
                xn[q * 8 + 0] = bflo(a.x) * rstd * g0[0] + s0[0]; xn[q * 8 + 1] = bfhi(a.x) * rstd * g0[1] + s0[1]; xn[q * 8 + 2] = bflo(a.y) * rstd * g0[2] + s0[2]; xn[q * 8 + 3] = bfhi(a.y) * rstd * g0[3] + s0[3];
                xn[q * 8 + 4] = bflo(a.z) * rstd * g1[0] + s1[0]; xn[q * 8 + 5] = bfhi(a.z) * rstd * g1[1] + s1[1]; xn[q * 8 + 6] = bflo(a.w) * rstd * g1[2] + s1[2]; xn[q * 8 + 7] = bfhi(a.w) * rstd * g1[3] + s1[3];
            }
        }
        int ni0 = 0, ni1 = 0; float ng0 = 0.f, ng1 = 0.f, nsq = 0.f; uint4 nh[4];
#pragma unroll
        for (int q = 0; q < 4; ++q) nh[q] = make_uint4(0u, 0u, 0u, 0u);
        if (has_next) {
            ni0 = IDX[(size_t)tn * 128 + lane]; ni1 = IDX[(size_t)tn * 128 + 64 + lane]; ng0 = GATE[(size_t)tn * 128 + lane]; ng1 = GATE[(size_t)tn * 128 + 64 + lane];
            nsq = lane < 32 ? SSQ[(size_t)tn * 32 + lane] : 0.f;
#pragma unroll
            for (int q = 0; q < 4; ++q) nh[q] = *(const uint4*)(H1b + (size_t)tn * DM + lane * 32 + q * 8);
        }
        __builtin_amdgcn_sched_barrier(0);
        const unsigned lo16 = (unsigned)lane * 16u, lo8 = 1024u + (unsigned)lane * 8u;
        f32x2v_t acc2[16], xn2[16];
#pragma unroll
        for (int j = 0; j < 16; ++j) { acc2[j] = (f32x2v_t){0.f, 0.f}; xn2[j] = (f32x2v_t){xn[2 * j], xn[2 * j + 1]}; }
        const int i0 = ci0, i1 = ci1;
        const int scsel = ((lane & 15) < PEER_NHI) ? 0 : 2 * 16384;
        const float su0 = csu0, su1 = csu1, gv0 = cg0 * csv0, gv1 = cg1 * csv1;
#define G_FINISH_U(K0) \
            float dsum = g_swap16_add(g_swap32_add(part[0], part[2]), g_swap32_add(part[1], part[3])); \
            dsum += g_dpp<0xB1>(dsum); dsum += g_dpp<0x4E>(dsum); dsum += g_dpp<0x141>(dsum); dsum += g_dpp<0x140>(dsum); \
            const int pl = (((K0) + (lane >> 4)) & 63); \
            const float su = __shfl((K0) < 64 ? su0 : su1, pl), gv = __shfl((K0) < 64 ? gv0 : gv1, pl); \
            const float w = gv * gelu_exact(dsum * su);
#define G_PIN16(X) asm volatile("" : "+v"(acc2[0]), "+v"(acc2[1]), "+v"(acc2[2]), "+v"(acc2[3]), "+v"(acc2[4]), "+v"(acc2[5]), "+v"(acc2[6]), "+v"(acc2[7]), \
                                  "+v"(acc2[8]), "+v"(acc2[9]), "+v"(acc2[10]), "+v"(acc2[11]), "+v"(acc2[12]), "+v"(acc2[13]), "+v"(acc2[14]), "+v"(acc2[15]), "+v"(X));
#define GB_LOAD(RU, RV, K0) { \
            const int isrc = (K0) < 64 ? i0 : i1; \
            unsigned l16 = lo16, l8 = lo8; asm volatile("" : "+v"(l16), "+v"(l8));        \
            _Pragma("unroll") for (int ki = 0; ki < 4; ++ki) { const unsigned eo = (unsigned)__builtin_amdgcn_readlane(isrc, (((K0) + ki) & 63)) * (unsigned)EROW;        \
                const unsigned char* rpu = EU + eo; { const u32x4_t a_ = *(const u32x4_t*)(rpu + l16); const u32x2_t b_ = *(const u32x2_t*)(rpu + l8); RU[ki] = (v6u_t){a_[0], a_[1], a_[2], a_[3], b_[0], b_[1]}; } \
                const unsigned char* rpv = EV + eo; { const u32x4_t a_ = *(const u32x4_t*)(rpv + l16); const u32x2_t b_ = *(const u32x2_t*)(rpv + l8); RV[ki] = (v6u_t){a_[0], a_[1], a_[2], a_[3], b_[0], b_[1]}; } } }
#define GB_COMP(RU, RV, K0) { \
            float part[4]; \
            _Pragma("unroll") for (int ki = 0; ki < 4; ++ki) { \
                const v32f_t f = __builtin_amdgcn_cvt_scalef32_pk32_f32_fp6(RU[ki], 1.0f); \
                f32x2v_t da = {0.f, 0.f}, db = {0.f, 0.f}, dc = {0.f, 0.f}, dd = {0.f, 0.f};        \
                _Pragma("unroll") for (int j = 0; j < 16; j += 4) { \
                    da = (f32x2v_t){f[2 * j], f[2 * j + 1]} * xn2[j] + da; db = (f32x2v_t){f[2 * j + 2], f[2 * j + 3]} * xn2[j + 1] + db; \
                    dc = (f32x2v_t){f[2 * j + 4], f[2 * j + 5]} * xn2[j + 2] + dc; dd = (f32x2v_t){f[2 * j + 6], f[2 * j + 7]} * xn2[j + 3] + dd; } \
                const f32x2v_t d2 = (da + db) + (dc + dd); \
                part[ki] = d2[0] + d2[1]; } \
            G_FINISH_U(K0) \
            _Pragma("unroll") for (int ki = 0; ki < 4; ++ki) { \
                const float wk = __builtin_bit_cast(float, __builtin_amdgcn_readlane(__builtin_bit_cast(int, w), 16 * ki)); \
                const f32x2v_t wk2 = {wk, wk}; \
                const v32f_t f = __builtin_amdgcn_cvt_scalef32_pk32_f32_fp6(RV[ki], 1.0f); \
                _Pragma("unroll") for (int j = 0; j < 16; ++j) { const f32x2v_t fv = {f[2 * j], f[2 * j + 1]}; acc2[j] = fv * wk2 + acc2[j]; } \
                G_PIN16(RV[ki < 3 ? ki + 1 : 3]) } }
#define G4_LOAD(RU, RV, K0) { \
            const int isrc = (K0) < 64 ? i0 : i1; \
            unsigned l16 = lo16; asm volatile("" : "+v"(l16)); \
            _Pragma("unroll") for (int ki = 0; ki < 4; ++ki) { const unsigned eo = (unsigned)__builtin_amdgcn_readlane(isrc, (((K0) + ki) & 63)) * (unsigned)EROW4; \
                RU[ki] = *(const u32x4_t*)(EU4 + eo + l16); RV[ki] = *(const u32x4_t*)(EV4 + eo + l16); } }
#define G4_COMP(RU, RV, K0) { \
            float part[4]; \
            _Pragma("unroll") for (int ki = 0; ki < 4; ++ki) { \
                f32x2v_t da = {0.f, 0.f}, db = {0.f, 0.f}, dc = {0.f, 0.f}, dd = {0.f, 0.f}; \
                _Pragma("unroll") for (int q = 0; q < 4; ++q) { const unsigned wq_ = RU[ki][q]; \
                    da = __builtin_amdgcn_cvt_scalef32_pk_f32_fp4(wq_, 1.0f, 0) * xn2[q * 4 + 0] + da; db = __builtin_amdgcn_cvt_scalef32_pk_f32_fp4(wq_, 1.0f, 1) * xn2[q * 4 + 1] + db; \
                    dc = __builtin_amdgcn_cvt_scalef32_pk_f32_fp4(wq_, 1.0f, 2) * xn2[q * 4 + 2] + dc; dd = __builtin_amdgcn_cvt_scalef32_pk_f32_fp4(wq_, 1.0f, 3) * xn2[q * 4 + 3] + dd; } \
                const f32x2v_t d2 = (da + db) + (dc + dd); \
                part[ki] = d2[0] + d2[1]; } \
            G_FINISH_U(K0) \
            _Pragma("unroll") for (int ki = 0; ki < 4; ++ki) { \
                const float wk = __builtin_bit_cast(float, __builtin_amdgcn_readlane(__builtin_bit_cast(int, w), 16 * ki)); \
                const f32x2v_t wk2 = {wk, wk}; \
                _Pragma("unroll") for (int q = 0; q < 4; ++q) { const unsigned wq_ = RV[ki][q]; \
                    acc2[q * 4 + 0] = __builtin_amdgcn_cvt_scalef32_pk_f32_fp4(wq_, 1.0f, 0) * wk2 + acc2[q * 4 + 0]; acc2[q * 4 + 1] = __builtin_amdgcn_cvt_scalef32_pk_f32_fp4(wq_, 1.0f, 1) * wk2 + acc2[q * 4 + 1]; \
                    acc2[q * 4 + 2] = __builtin_amdgcn_cvt_scalef32_pk_f32_fp4(wq_, 1.0f, 2) * wk2 + acc2[q * 4 + 2]; acc2[q * 4 + 3] = __builtin_amdgcn_cvt_scalef32_pk_f32_fp4(wq_, 1.0f, 3) * wk2 + acc2[q * 4 + 3]; } \
                G_PIN16(RV[ki < 3 ? ki + 1 : 3]) } }
        if (PEER_NHI > 0) {
            constexpr int NG6 = PEER_NHI / 4, NB6 = 8 * NG6;
            v6u_t ruA[4], rvA[4], ruB[4], rvB[4];
#define K6(B) (((B) / NG6) * 16 + ((B) % NG6) * 4)
            GB_LOAD(ruA, rvA, K6(0))
#pragma unroll 1
            for (int b6 = 0; b6 < NB6; b6 += 2) {
                GB_LOAD(ruB, rvB, K6(b6 + 1))
                GB_COMP(ruA, rvA, K6(b6))
                if (b6 + 2 < NB6) GB_LOAD(ruA, rvA, K6(b6 + 2))
                GB_COMP(ruB, rvB, K6(b6 + 1))
            }
#undef K6
        }
        if (PEER_NHI < 16) {
            constexpr int NG4 = (16 - PEER_NHI) / 4, NB4 = 8 * NG4;
            u32x4_t quA[4], qvA[4], quB[4], qvB[4];
#define K4(B) (((B) / NG4) * 16 + PEER_NHI + ((B) % NG4) * 4)
            G4_LOAD(quA, qvA, K4(0))
#pragma unroll 1
            for (int b4 = 0; b4 < NB4; b4 += 2) {
                G4_LOAD(quB, qvB, K4(b4 + 1))
                G4_COMP(quA, qvA, K4(b4))
                if (b4 + 2 < NB4) G4_LOAD(quA, qvA, K4(b4 + 2))
                G4_COMP(quB, qvB, K4(b4 + 1))
            }
#undef K4
        }
#undef G4_LOAD
#undef G4_COMP
#undef G_FINISH_U
#undef G_PIN16
#undef GB_LOAD
#undef GB_COMP
        float acc[32];
#pragma unroll
        for (int j = 0; j < 16; ++j) { acc[2 * j] = acc2[j][0]; acc[2 * j + 1] = acc2[j][1]; }
        float nsu0 = 0.f, nsu1 = 0.f, nsv0 = 0.f, nsv1 = 0.f;
        if (has_next) { nsu0 = ESC[scsel + ni0]; nsu1 = ESC[scsel + ni1]; nsv0 = ESC[scsel + 16384 + ni0]; nsv1 = ESC[scsel + 16384 + ni1]; }
        float ss2 = 0.f;
        {
            const PG8_LAS float* g2l = (const PG8_LAS float*)gvl + 4 * DM + (t >> 14) * DM + lane * 32;
#pragma unroll
            for (int q = 0; q < 4; ++q) {
                const uint4 hh = ch[q];
                const f32x4_t g20 = *(const PG8_LAS f32x4_t*)(g2l + q * 8), g21 = *(const PG8_LAS f32x4_t*)(g2l + q * 8 + 4);
                acc[q * 8 + 0] = bflo(hh.x) + g20[0] * acc[q * 8 + 0]; acc[q * 8 + 1] = bfhi(hh.x) + g20[1] * acc[q * 8 + 1];
                acc[q * 8 + 2] = bflo(hh.y) + g20[2] * acc[q * 8 + 2]; acc[q * 8 + 3] = bfhi(hh.y) + g20[3] * acc[q * 8 + 3];
                acc[q * 8 + 4] = bflo(hh.z) + g21[0] * acc[q * 8 + 4]; acc[q * 8 + 5] = bfhi(hh.z) + g21[1] * acc[q * 8 + 5];
                acc[q * 8 + 6] = bflo(hh.w) + g21[2] * acc[q * 8 + 6]; acc[q * 8 + 7] = bfhi(hh.w) + g21[3] * acc[q * 8 + 7];
            }
        }
#pragma unroll
        for (int j = 0; j < 32; ++j) ss2 += acc[j] * acc[j];
        ss2 = wave_sum(ss2);
        const float rs2 = rsqrtf(ss2 * (1.0f / DM) + EPS);
        {
            const PG8_LAS float* fgl = (const PG8_LAS float*)gvl + 6 * DM + lane * 32;
#pragma unroll
            for (int q = 0; q < 8; ++q) {
                const f32x4_t fg = *(const PG8_LAS f32x4_t*)(fgl + q * 4);
                float4 o;
                o.x = acc[q * 4 + 0] * rs2 * fg[0]; o.y = acc[q * 4 + 1] * rs2 * fg[1]; o.z = acc[q * 4 + 2] * rs2 * fg[2]; o.w = acc[q * 4 + 3] * rs2 * fg[3];
                *(float4*)(p.out + (size_t)t * DM + lane * 32 + q * 4) = o;
            }
        }
        ci0 = ni0; ci1 = ni1; cg0 = ng0; cg1 = ng1; csq = nsq; csu0 = nsu0; csu1 = nsu1; csv0 = nsv0; csv1 = nsv1;
#pragma unroll
        for (int q = 0; q < 4; ++q) ch[q] = nh[q];
    }
}

#define LAS __attribute__((address_space(3)))
#define XB_TMO      128
#define XB_XCNT(j)  (256  + 64 * (j))
#define XB_XSUB(j)  (1280 + 64 * (j))
#define XB_XGEN(j)  (2304 + 64 * (j))
#define XB_TOP      3328
#define XB_TOPGEN   3392
#define XCD_BAR_WORDS 3456
#define XB_SPIN_CAP (1u << 18)

__device__ __forceinline__ unsigned xb_ld(unsigned* p)              { return __hip_atomic_load(p, __ATOMIC_RELAXED, __HIP_MEMORY_SCOPE_AGENT); }
__device__ __forceinline__ unsigned xb_add(unsigned* p, unsigned v) { return __hip_atomic_fetch_add(p, v, __ATOMIC_RELAXED, __HIP_MEMORY_SCOPE_AGENT); }
__device__ __forceinline__ unsigned xb_xcc_id() { return (unsigned)__builtin_amdgcn_s_getreg((3 << 11) | 20) & 0xFu; }
#define XB_SPIN(cond, bar) do { unsigned _sp = 0; while (cond) { __builtin_amdgcn_s_sleep(1); \
    if ((++_sp & 255u) == 0u) { if (xb_ld(&(bar)[XB_TMO])) break; if (_sp > XB_SPIN_CAP) { atomicAdd(&(bar)[XB_TMO], 1u); break; } } } } while (0)

struct XcdBarrier {
    unsigned* bar; unsigned x;
    volatile LAS unsigned* st;
};

__device__ __forceinline__ XcdBarrier xcd_barrier_post(unsigned* bar, volatile LAS unsigned* st) {
    XcdBarrier b; b.bar = bar; b.x = xb_xcc_id(); b.st = st;
    if (threadIdx.x == 0) (void)xb_add(&bar[XB_XCNT(b.x)], 1u);
    return b;
}
__device__ __forceinline__ void xcd_barrier_complete(unsigned* bar, unsigned x, unsigned& nloc, unsigned& nx) {
    const unsigned G = gridDim.x * gridDim.y * gridDim.z;
    unsigned sum, cnt, mine, sp = 0u;
    for (;;) {
        sum = 0u; cnt = 0u; mine = 0u;
#pragma unroll
        for (unsigned j = 0; j < 16; ++j) { const unsigned c = xb_ld(&bar[XB_XCNT(j)]); sum += c; cnt += (c > 0u) ? 1u : 0u; mine = (j == x) ? c : mine; }
        if (sum == G) break;
        __builtin_amdgcn_s_sleep(1);
        if ((++sp & 255u) == 0u) { if (xb_ld(&bar[XB_TMO])) break; if (sp > XB_SPIN_CAP) { atomicAdd(&bar[XB_TMO], 1u); break; } }
    }
    nloc = mine > 0u ? mine : 1u; nx = cnt > 0u ? cnt : 1u;
}

__device__ __forceinline__ void xcd_barrier(const XcdBarrier& b) {
    asm volatile("s_waitcnt vmcnt(0)" ::: "memory");
    __syncthreads();
    if (threadIdx.x == 0) {
        unsigned* bar = b.bar;
        __builtin_amdgcn_s_waitcnt(0);
        unsigned nloc = b.st[0], nx = b.st[1];
        if (nloc == 0u) { xcd_barrier_complete(bar, b.x, nloc, nx); b.st[0] = nloc; b.st[1] = nx; }
        const unsigned old = xb_add(&bar[XB_XSUB(b.x)], 1u);
        const unsigned gen = old / nloc;
        if (old + 1u == (gen + 1u) * nloc) {
            __builtin_amdgcn_fence(__ATOMIC_RELEASE, "agent");
            asm volatile("s_waitcnt vmcnt(0)" ::: "memory");
            const unsigned og = xb_add(&bar[XB_TOP], 1u);
            const unsigned tg = og / nx;
            if (og + 1u == (tg + 1u) * nx) xb_add(&bar[XB_TOPGEN], 1u);
            else XB_SPIN(xb_ld(&bar[XB_TOPGEN]) == tg, bar);
            __builtin_amdgcn_fence(__ATOMIC_ACQUIRE, "agent");
            xb_add(&bar[XB_XGEN(b.x)], 1u);
            asm volatile("s_waitcnt vmcnt(0)" ::: "memory");
        } else {
            XB_SPIN(xb_ld(&bar[XB_XGEN(b.x)]) == gen, bar);
            __builtin_amdgcn_fence(__ATOMIC_ACQUIRE, "agent");
            asm volatile("s_waitcnt vmcnt(0)" ::: "memory");
        }
    }
    __syncthreads();
}


constexpr int LDS_BARST = LDS_BYTES - 16;

constexpr int N_STAGES = 12;
template <int S>
__device__ __forceinline__ void run_stage(const Params& p, unsigned char* smem) {
    const int bid = blockIdx.x, nb = gridDim.x;
    PG8_LAS unsigned char* lds3 = (PG8_LAS unsigned char*)smem;
    if constexpr (S == 0) { st_mod_partial(p, bid, nb); st_wprep(p, bid, nb, smem); st_econv(p, bid, nb); }
    if constexpr (S == 1) { st_mod_final(p, bid, nb); }
    if constexpr (S == 2) { st_wprep_q(p, bid, nb, smem); st_normmod(p, p.in[I_X], p.in[I_CTX], TALL, p.in[I_N1G], 0, DM, bid, nb); }
    if constexpr (S == 3) { pg8::Gemm g{(const bf16_t*)(p.ws + WS_A), (const bf16_t*)(p.ws + WS_BT1), TALL, NP, DM}; pg8::StaticOrder S_; S_.init(TALL, NP, nb, bid);
              EpiP E{(bf16_t*)(p.ws + WS_P), NP}; pg8::gemm_phase<EpiP, pg8::StaticOrder, GEMM_ALIGN_EPI, GEMM_SP2>(lds3, g, S_, E); }
    if constexpr (S == 4) { st_cq_final(p, bid); st_gla_passA(p, bid, nb, smem); st_cmlp_mfma(p, bid, nb, smem);
#if defined(PROBE_SUB) && PROBE_SUB == 1
        __syncthreads(); st_gla_passA(p, bid, nb, smem);
#elif defined(PROBE_SUB) && PROBE_SUB == 2
        __syncthreads(); st_cmlp_mfma(p, bid, nb, smem);
#endif
    }
    if constexpr (S == 5) {
#if defined(PROBE_SUB) && PROBE_SUB == 3
        st_gla_passB<true>(p, bid, nb); __syncthreads();
#endif
        st_gla_passB<false>(p, bid, nb); }
    if constexpr (S == 6) { st_gla_passC(p, bid, nb, smem); }
    if constexpr (S == 7) { pg8::Gemm g{(const bf16_t*)(p.ws + WS_A), (const bf16_t*)(p.ws + WS_BT2), TLAT, DM, DM}; pg8::StaticOrder S_; S_.init(TLAT, DM, nb, bid);
              EpiH1 E{(bf16_t*)(p.ws + WS_H1), p.in[I_X], (const float*)(p.ws + WS_M), (float*)(p.ws + WS_SSQ)}; pg8::gemm_phase<EpiH1, pg8::StaticOrder, GEMM_ALIGN_EPI, GEMM_SP2>(lds3, g, S_, E); }
    if constexpr (S == 9) { pg8::Gemm g{(const bf16_t*)(p.ws + WS_H1), (const bf16_t*)(p.ws + WS_BT3), TLAT, DM, DM}; pg8::StaticOrder S_; S_.init(TLAT, DM, nb, bid);
              EpiQ E{(bf16_t*)(p.ws + WS_Q), (const float*)(p.ws + WS_SSQ), (const float*)(p.ws + WS_CQ)}; pg8::gemm_phase<EpiQ, pg8::StaticOrder, GEMM_ALIGN_EPI, GEMM_SP2>(lds3, g, S_, E); }
    if constexpr (S == 10) { st_topk_mfma(p, bid, nb, smem); }
    if constexpr (S == 11) { st_gather(p, bid, nb, smem); }
}

template <int LO, int HI>
__global__ void __launch_bounds__(NTHR, 2) k_fwd(Params p) {
    extern __shared__ __attribute__((aligned(16))) unsigned char smem[];
#ifndef PROBE_DUP
#define PROBE_DUP (-1)
#endif
    constexpr bool MEGA = (HI - LO) > 1;
    XcdBarrier xbar; xbar.bar = nullptr; xbar.x = 0; xbar.st = nullptr;
    if constexpr (MEGA) {
        volatile LAS unsigned* st = (volatile LAS unsigned*)((LAS unsigned char*)smem + LDS_BARST);
        if (threadIdx.x < 2) st[threadIdx.x] = 0u;
        __syncthreads();
        xbar = xcd_barrier_post((unsigned*)(p.ws + WS_BAR), st);
    }
#define SEAM(k) { if constexpr (k == LO) cg::this_grid().sync(); else xcd_barrier(xbar); }
#define RUN_ST(k) if constexpr (LO <= k && k < HI && k != 8) { run_stage<k>(p, smem); if constexpr (k == PROBE_DUP) { SEAM(k) run_stage<k>(p, smem); } if constexpr (k + 1 < HI) SEAM(k) }
    RUN_ST(0) RUN_ST(1) RUN_ST(2) RUN_ST(3) RUN_ST(4) RUN_ST(5) RUN_ST(6) RUN_ST(7) RUN_ST(8) RUN_ST(9) RUN_ST(10) RUN_ST(11)
#undef RUN_ST
#undef SEAM
}

#ifndef N_LAUNCH_MODE
#define N_LAUNCH_MODE 0
#endif

template <int S> static void launch_stage(const Params& p, int grid, hipStream_t stream) {
    static bool attr_done = false;
    if (!attr_done) { hipFuncSetAttribute((const void*)k_fwd<S, S + 1>, hipFuncAttributeMaxDynamicSharedMemorySize, LDS_BYTES); attr_done = true; }
    hipLaunchKernelGGL((k_fwd<S, S + 1>), dim3(grid), dim3(NTHR), LDS_BYTES, stream, p);
}

extern "C" void kernel_launch(void* const* d_in, const int* in_sizes, int n_in, void* d_out, int out_size, void* d_ws, size_t ws_size, hipStream_t stream) {
    static int grid = 0;
    if (grid == 0) {
        if (n_in != N_IN || ws_size < WS_END) { fprintf(stderr, "kernel_launch: unexpected n_in %d / ws_size %zu (need %zu)\n", n_in, ws_size, (size_t)WS_END); grid = -1; return; }
        int dev = 0, cus = 0;
        hipGetDevice(&dev);
        hipDeviceGetAttribute(&cus, hipDeviceAttributeMultiprocessorCount, dev);
#if N_LAUNCH_MODE == 1
        int per_cu = 0;
        hipFuncSetAttribute((const void*)k_fwd<0, N_STAGES>, hipFuncAttributeMaxDynamicSharedMemorySize, LDS_BYTES);
        hipOccupancyMaxActiveBlocksPerMultiprocessor(&per_cu, (const void*)k_fwd<0, N_STAGES>, NTHR, LDS_BYTES);
        if (per_cu < 1) fprintf(stderr, "kernel_launch: occupancy query says %d blocks/CU\n", per_cu);
#endif
        grid = cus;
        (void)hipGetLastError();
    }
    if (grid < 0) return;
    Params p{};
    for (int i = 0; i < N_IN; ++i) p.in[i] = (const float*)d_in[i];
    p.out = (float*)d_out; p.ws = (unsigned char*)d_ws;
#if N_LAUNCH_MODE == 0
    launch_stage<0>(p, grid, stream); launch_stage<1>(p, grid, stream); launch_stage<2>(p, grid, stream); launch_stage<3>(p, grid, stream);
    launch_stage<4>(p, grid, stream); launch_stage<5>(p, grid, stream); launch_stage<6>(p, grid, stream); launch_stage<7>(p, grid, stream);
    launch_stage<8>(p, grid, stream); launch_stage<9>(p, grid, stream); launch_stage<10>(p, grid, stream); launch_stage<11>(p, grid, stream);
#else
    hipMemsetAsync((unsigned char*)d_ws + WS_BAR, 0, WS_BAR_BYTES, stream);
    void* args[] = {&p};
    hipError_t e = hipLaunchCooperativeKernel((const void*)k_fwd<0, N_STAGES>, dim3(grid), dim3(NTHR), args, LDS_BYTES, stream);
    if (e != hipSuccess) fprintf(stderr, "cooperative launch failed: %s (grid %d)\n", hipGetErrorString(e), grid);
#endif
}
```

```cpp
#include <hip/hip_runtime.h>
#include <hip/hip_cooperative_groups.h>
#include <cstdio>
#include <cstdint>
#define N_LAUNCH_MODE 1
#define PEER_NHI_SET 0
namespace pg8 {
#define PG8_LAS __attribute__((address_space(3)))
typedef unsigned short bf16_t;
typedef short bf16x8 __attribute__((ext_vector_type(8)));
typedef float f32x4 __attribute__((ext_vector_type(4)));
typedef unsigned u32x4 __attribute__((ext_vector_type(4)));
constexpr int BM = 256, BK = 64, HALF = 128, HTB = HALF * BK * 2  , STAGE_BYTES = 8 * HTB, NXCD = 8, WGM = 8;

__host__ __device__ __forceinline__ int lds_byte(int r, int c) { const int st = (r >> 4) * 2 + (c >> 5), rr = r & 15, cc = c & 31, ob = rr * 64 + cc * 2; return st * 1024 + (ob ^ (((ob >> 9) & 1) << 5)); }
__host__ __device__ __forceinline__ void stage_rc(int b, int& R, int& C) { const int st = b / 1024, sb = b % 1024, swz = sb ^ (((sb >> 9) & 1) << 5); R = (st >> 1) * 16 + swz / 64; C = (st & 1) * 32 + (swz % 64) / 2; }
__host__ __device__ __forceinline__ int perm32(int rho) { const int n = rho >> 4, i = rho & 15; return 8 * (i >> 2) + 4 * n + (i & 3); }

struct Unit { int pm, pn; };
struct Gemm { const bf16_t* A; const bf16_t* Bt; int M, N, K; };

struct StaticOrder {
    int nM, nN, nwg, G, c;
    __host__ __device__ void init(int M, int N, int G_, int c_) { nM = M / BM; nN = N / BM; nwg = nM * nN; G = G_; c = c_; }
    __host__ __device__ bool next(int i, Unit& u) const {
        const long L = (long)i * G + c; if (L >= nwg) return false;
        int wgid = (int)L; { const int q = nwg / NXCD, r = nwg % NXCD, xcd = wgid % NXCD, off = wgid / NXCD; wgid = (xcd < r ? xcd * (q + 1) : r * (q + 1) + (xcd - r) * q) + off; }
        const int nig = WGM * nN, gid = wgid / nig, fm = gid * WGM, gsz = (nM - fm) < WGM ? (nM - fm) : WGM;
        u.pm = fm + ((wgid % nig) % gsz); u.pn = (wgid % nig) / gsz; return true;
    }
    __device__ __forceinline__ void a_ready(const Unit&) const {}
    __device__ __forceinline__ void done(const Unit&) const {}
};
__device__ __forceinline__ unsigned cvt_pk_bf16(float lo, float hi) { unsigned r; asm volatile("v_cvt_pk_bf16_f32 %0, %1, %2" : "=v"(r) : "v"(lo), "v"(hi)); return r; }
typedef float f32x2 __attribute__((ext_vector_type(2)));
__device__ __forceinline__ f32x2 gelu_pk(f32x2 v) {
    const f32x2 av = __builtin_elementwise_abs(v), d = av * 0.2316418882f + 1.0f;
    f32x2 t; t.x = __builtin_amdgcn_rcpf(d.x); t.y = __builtin_amdgcn_rcpf(d.y);
    f32x2 q = t * 0.5307027145f + (-0.7265760135f); q = q * t + 0.7107068705f; q = q * t + (-0.142248368f); q = q * t + 0.127414796f; q = q * t;
    const f32x2 s = (v * v) * (-0.72134752044f);
    f32x2 e; e.x = __builtin_amdgcn_exp2f(s.x); e.y = __builtin_amdgcn_exp2f(s.y);
    const f32x2 m = v * (q * e), r = v - m;
    f32x2 o; o.x = v.x < 0.f ? m.x : r.x; o.y = v.y < 0.f ? m.y : r.y; return o;
}

struct EpiF32 {
    static constexpr bool PERM = false, AFTER_DRAIN = false;
    float* C; int ldc; const float* bias;
    __device__ __forceinline__ void operator()(const f32x4 (&acc)[2][2][4][2], const Unit& u, int wr, int wc, int fr, int fq) const {
        const int row0 = u.pm * BM + wr * 64 + fr, col0 = u.pn * BM + wc * 32 + 4 * fq;
        f32x4 bv[2][2];
#pragma unroll
        for (int bj = 0; bj < 2; ++bj)
#pragma unroll
            for (int n = 0; n < 2; ++n) bv[bj][n] = bias ? *(const f32x4*)(bias + col0 + bj * HALF + n * 16) : (f32x4){0.f, 0.f, 0.f, 0.f};
#pragma unroll
        for (int ai = 0; ai < 2; ++ai)
#pragma unroll
            for (int m = 0; m < 4; ++m) { float* rowp = C + (size_t)(row0 + ai * HALF + m * 16) * ldc + col0;
#pragma unroll
                for (int bj = 0; bj < 2; ++bj)
#pragma unroll
                    for (int n = 0; n < 2; ++n) *(f32x4*)(rowp + bj * HALF + n * 16) = acc[ai][bj][m][n] + bv[bj][n]; }
    }
};
template <class Epi, class Sched, bool ALIGN_EPI = false, bool SP2 = false>
__device__ __forceinline__ void gemm_phase(PG8_LAS unsigned char* lds, const Gemm g, const Sched& S, const Epi& E) {
    int tid_ = threadIdx.x; asm volatile("" : "+v"(tid_));
    const int tid = tid_, wid = __builtin_amdgcn_readfirstlane(tid >> 6), lane = tid & 63, wr = wid >> 2, wc = wid & 3, fr = lane & 15, fq = lane >> 4;
    const int K = g.K, nt = K / BK;
    unsigned voffA[2], voffB[2];
#pragma unroll
    for (int i = 0; i < 2; ++i) { int R, C; stage_rc(tid * 16 + i * 8192, R, C); const int Rb = Epi::PERM ? ((R & ~31) + perm32(R & 31)) : R;
        voffA[i] = (unsigned)(R * K + C) * 2u; voffB[i] = (unsigned)(Rb * K + C) * 2u; }
    const size_t kstep = (size_t)(BK * 2);
    const size_t hstep = (size_t)HALF * K * 2;
    const size_t tstep = 2 * hstep;
    const unsigned ldsw = (unsigned)wid * 1024u;
    const int aoff = lds_byte(wr * 64 + fr, fq * 8), boff = lds_byte(wc * 32 + fr, fq * 8);
#define PG8_SA(b, h) (((b) * 2 + (h)) * HTB)
#define PG8_SB(b, h) ((4 + (b) * 2 + (h)) * HTB)
#define PG8_STAGE(bufoff, gbase, voff) do { _Pragma("unroll") for (int _i = 0; _i < 2; ++_i) \
        __builtin_amdgcn_global_load_lds((const unsigned*)((const char*)(gbase) + (voff)[_i]), (PG8_LAS unsigned*)(lds + (bufoff) + ldsw + _i * 8192), 16, 0, 0); } while (0)
#define PG8_LDA(dst, b, h) do { _Pragma("unroll") for (int m = 0; m < 4; ++m) _Pragma("unroll") for (int k = 0; k < 2; ++k) dst[m][k] = *(const PG8_LAS bf16x8*)(lds + PG8_SA(b, h) + aoff + m * 2048 + k * 1024); } while (0)
#define PG8_LDB(dst, b, h) do { _Pragma("unroll") for (int n = 0; n < 2; ++n) _Pragma("unroll") for (int k = 0; k < 2; ++k) dst[n][k] = *(const PG8_LAS bf16x8*)(lds + PG8_SB(b, h) + boff + n * 2048 + k * 1024); } while (0)
#define PG8_MMA(ai, bj, At, Bt) do { __builtin_amdgcn_s_setprio(1); _Pragma("unroll") for (int m = 0; m < 4; ++m) _Pragma("unroll") for (int n = 0; n < 2; ++n) _Pragma("unroll") for (int k = 0; k < 2; ++k) \
        acc[ai][bj][m][n] = __builtin_amdgcn_mfma_f32_16x16x32_bf16(Bt[n][k], At[m][k], acc[ai][bj][m][n], 0, 0, 0); __builtin_amdgcn_s_setprio(0); } while (0)
#define PG8_WAIT_V(n) asm volatile("s_waitcnt vmcnt(" #n ")" ::: "memory")
#define PG8_WAIT_L(n) asm volatile("s_waitcnt lgkmcnt(" #n ")" ::: "memory")
#define PG8_BAR __builtin_amdgcn_s_barrier()
#define PG8_SCHED __builtin_amdgcn_sched_barrier(0)
    Unit cur, nxt; int ui = 0;
    if (!S.next(0, cur)) return;
    f32x4 acc[2][2][4][2];
#pragma unroll
    for (int a = 0; a < 2; ++a)
#pragma unroll
        for (int b = 0; b < 2; ++b)
#pragma unroll
            for (int m = 0; m < 4; ++m)
#pragma unroll
                for (int n = 0; n < 2; ++n) acc[a][b][m][n] = (f32x4){0.f, 0.f, 0.f, 0.f};
    bf16x8 At[4][2], B0[2][2], B1[2][2];
    const char* cA = (const char*)g.A + (size_t)cur.pm * tstep; const char* cB = (const char*)g.Bt + (size_t)E.btile(cur) * tstep;
    S.a_ready(cur);
    if constexpr (SP2) {
        PG8_STAGE(PG8_SB(0, 0), cB, voffB); PG8_STAGE(PG8_SB(0, 1), cB + hstep, voffB); PG8_STAGE(PG8_SA(0, 0), cA, voffA); PG8_STAGE(PG8_SA(0, 1), cA + hstep, voffA);
        if (wr == 1) PG8_BAR;
        PG8_WAIT_V(2); PG8_BAR;
        PG8_STAGE(PG8_SB(1, 0), cB + kstep, voffB); PG8_STAGE(PG8_SA(1, 0), cA + kstep, voffA); PG8_STAGE(PG8_SB(1, 1), cB + hstep + kstep, voffB);
        PG8_WAIT_V(6); PG8_BAR;
    } else {
        PG8_STAGE(PG8_SB(0, 0), cB, voffB); PG8_STAGE(PG8_SA(0, 0), cA, voffA); PG8_STAGE(PG8_SB(0, 1), cB + hstep, voffB); PG8_STAGE(PG8_SA(0, 1), cA + hstep, voffA);
        if (wr == 1) PG8_BAR;
        PG8_WAIT_V(4); PG8_BAR;
        PG8_STAGE(PG8_SB(1, 0), cB + kstep, voffB); PG8_STAGE(PG8_SA(1, 0), cA + kstep, voffA); PG8_STAGE(PG8_SB(1, 1), cB + hstep + kstep, voffB);
        PG8_WAIT_V(6); PG8_BAR;
    }
    for (;;) {
        const bool has_next = S.next(ui + 1, nxt);
        const char* nA = has_next ? (const char*)g.A + (size_t)nxt.pm * tstep : cA; const char* nB = has_next ? (const char*)g.Bt + (size_t)E.btile(nxt) * tstep : cB;
        for (int t = 0; t < nt; t += 2) {
            const bool last = (t == nt - 2);
            const char* a1 = cA + (size_t)(t + 1) * kstep;
            const char* a2 = last ? nA : cA + (size_t)(t + 2) * kstep; const char* b2 = last ? nB : cB + (size_t)(t + 2) * kstep;
            const char* a3 = a2 + kstep; const char* b3 = b2 + kstep;
            if (last && has_next) S.a_ready(nxt);
            if constexpr (SP2) {
            PG8_LDB(B0, 0, 0); PG8_LDB(B1, 0, 1); PG8_SCHED; PG8_LDA(At, 0, 0); PG8_STAGE(PG8_SA(1, 1), a1 + hstep, voffA);
            PG8_WAIT_V(8); PG8_WAIT_L(0); PG8_BAR; PG8_MMA(0, 0, At, B0); PG8_MMA(0, 1, At, B1); PG8_BAR; PG8_SCHED;
            PG8_LDA(At, 0, 1); PG8_STAGE(PG8_SB(0, 0), b2, voffB); PG8_STAGE(PG8_SB(0, 1), b2 + hstep, voffB); PG8_STAGE(PG8_SA(0, 0), a2, voffA);
            PG8_WAIT_V(8); PG8_WAIT_L(0); PG8_BAR; PG8_MMA(1, 0, At, B0); PG8_MMA(1, 1, At, B1); PG8_BAR; PG8_SCHED;
            PG8_LDB(B0, 1, 0); PG8_LDB(B1, 1, 1); PG8_SCHED; PG8_LDA(At, 1, 0); PG8_STAGE(PG8_SA(0, 1), a2 + hstep, voffA);
            PG8_WAIT_V(8); PG8_WAIT_L(0); PG8_BAR; PG8_MMA(0, 0, At, B0); PG8_MMA(0, 1, At, B1); PG8_BAR; PG8_SCHED;
            PG8_LDA(At, 1, 1); PG8_STAGE(PG8_SB(1, 0), b3, voffB); PG8_STAGE(PG8_SB(1, 1), b3 + hstep, voffB); PG8_STAGE(PG8_SA(1, 0), a3, voffA);
            PG8_WAIT_V(8); PG8_WAIT_L(0); PG8_BAR; PG8_MMA(1, 0, At, B0); PG8_MMA(1, 1, At, B1); PG8_BAR; PG8_SCHED;
            } else {
            PG8_LDB(B0, 0, 0); PG8_SCHED; PG8_LDA(At, 0, 0); PG8_STAGE(PG8_SA(1, 1), a1 + hstep, voffA);
            PG8_WAIT_L(8); PG8_BAR; PG8_WAIT_L(0); PG8_MMA(0, 0, At, B0); PG8_BAR; PG8_SCHED;
            PG8_LDB(B1, 0, 1); PG8_STAGE(PG8_SB(0, 0), b2, voffB);
            PG8_BAR; PG8_WAIT_L(0); PG8_MMA(0, 1, At, B1); PG8_BAR;
            PG8_LDA(At, 0, 1); PG8_STAGE(PG8_SA(0, 0), a2, voffA);
            PG8_BAR; PG8_WAIT_L(0); PG8_MMA(1, 0, At, B0); PG8_BAR; PG8_SCHED;
            PG8_STAGE(PG8_SB(0, 1), b2 + hstep, voffB);
            PG8_WAIT_V(6); PG8_BAR; PG8_MMA(1, 1, At, B1); PG8_BAR;
            PG8_LDB(B0, 1, 0); PG8_SCHED; PG8_LDA(At, 1, 0); PG8_STAGE(PG8_SA(0, 1), a2 + hstep, voffA);
            PG8_WAIT_L(8); PG8_BAR; PG8_WAIT_L(0); PG8_MMA(0, 0, At, B0); PG8_BAR; PG8_SCHED;
            PG8_LDB(B1, 1, 1); PG8_STAGE(PG8_SB(1, 0), b3, voffB);
            PG8_BAR; PG8_WAIT_L(0); PG8_MMA(0, 1, At, B1); PG8_BAR;
            PG8_LDA(At, 1, 1); PG8_STAGE(PG8_SA(1, 0), a3, voffA);
            PG8_BAR; PG8_WAIT_L(0); PG8_MMA(1, 0, At, B0); PG8_BAR; PG8_SCHED;
            PG8_STAGE(PG8_SB(1, 1), b3 + hstep, voffB);
            PG8_WAIT_V(6); PG8_BAR; PG8_MMA(1, 1, At, B1); PG8_BAR;
            }
        }
        if constexpr (ALIGN_EPI) { if (wr == 0) PG8_BAR; }
        if constexpr (!Epi::AFTER_DRAIN) { E(acc, cur, wr, wc, fr, fq); S.done(cur); }
        if (!has_next) break;
#pragma unroll
        for (int a = 0; a < 2; ++a)
#pragma unroll
            for (int b = 0; b < 2; ++b)
#pragma unroll
                for (int m = 0; m < 4; ++m)
#pragma unroll
                    for (int n = 0; n < 2; ++n) acc[a][b][m][n] = (f32x4){0.f, 0.f, 0.f, 0.f};
        cur = nxt; cA = nA; cB = nB; ++ui;
        if constexpr (ALIGN_EPI) { if (wr == 1) PG8_BAR; }
    }
    PG8_WAIT_V(0);
    if constexpr (!ALIGN_EPI) { if (wr == 0) PG8_BAR; }
    PG8_BAR;
    if constexpr (Epi::AFTER_DRAIN) { E.fused(acc, cur, wr, wc, fr, fq, lds, wid, lane); S.done(cur); }
#undef PG8_SA
#undef PG8_SB
#undef PG8_STAGE
#undef PG8_LDA
#undef PG8_LDB
#undef PG8_MMA
#undef PG8_WAIT_V
#undef PG8_WAIT_L
#undef PG8_BAR
#undef PG8_SCHED
}
}

namespace cg = cooperative_groups;
typedef unsigned short bf16_t;
typedef __bf16 bf16x2_t __attribute__((ext_vector_type(2)));

constexpr int DM = 2048, TLAT = 32768, TALL = 33280, SEQ = 16384, CTXL = 256;
constexpr int NP = 5376;
constexpr int PC_Q = 0, PC_K = 512, PC_V = 1024, PC_G = 2048, PC_U = 3072, PC_V2 = 4096, PC_LR = 5120;
constexpr float EPS = 1e-6f;
constexpr int NTHR = 512;
#ifndef GEMM_ALIGN_EPI
#define GEMM_ALIGN_EPI false
#endif
#ifndef GEMM_SP2
#define GEMM_SP2 true
#endif
constexpr int LDS_BYTES = 156160;
#ifndef PEER_NHI_SET
#define PEER_NHI_SET 4
#endif
constexpr int PEER_NHI = PEER_NHI_SET;

enum { I_X = 0, I_C, I_CTX, I_CCTX, I_N1G, I_N2G, I_WMOD, I_BMOD, I_WIN, I_WGU, I_BG, I_GNG, I_LNG, I_LNB, I_WS, I_BS, I_WOUT, I_WQ, I_SK, I_PU, I_PV, I_FNG, N_IN };

constexpr size_t WS_BAR   = 0;
constexpr size_t WS_BAR_BYTES = 16384;
constexpr size_t WS_MPART = WS_BAR_BYTES;
constexpr size_t WS_M     = WS_MPART + (size_t)32 * 3 * 12288 * 4;
constexpr size_t WS_BT1   = WS_M + (size_t)3 * 12288 * 4;
constexpr size_t WS_BT2   = WS_BT1 + (size_t)NP * DM * 2;
constexpr size_t WS_BT3   = WS_BT2 + (size_t)DM * DM * 2;
constexpr int    EROW     = 1536;
constexpr size_t WS_EU    = WS_BT3 + (size_t)2 * DM * DM * 2;
constexpr size_t WS_EV    = WS_EU + (PEER_NHI > 0 ? (size_t)16384 * EROW : (size_t)0);
constexpr size_t WS_ESC   = WS_EV + (PEER_NHI > 0 ? (size_t)16384 * EROW : (size_t)0);
constexpr int    EROW4    = 1024;
constexpr size_t WS_EU4   = WS_ESC + (size_t)4 * 16384 * 4;
constexpr size_t WS_EV4   = WS_EU4 + (size_t)16384 * EROW4;
constexpr size_t WS_A     = WS_EV4 + (size_t)16384 * EROW4;
constexpr size_t WS_P     = WS_A + (size_t)TALL * DM * 2;
constexpr size_t WS_H1    = WS_P;
constexpr int    GL_NS    = 260;
constexpr size_t WS_ST    = WS_P + (size_t)TALL * NP * 2;
constexpr size_t WS_Q     = WS_ST;
constexpr size_t WS_DEC   = WS_ST + (size_t)16 * GL_NS * 32768 * 2;
constexpr size_t WS_IDX   = WS_DEC + (size_t)16 * GL_NS * 128 * 4;
constexpr size_t WS_GATE  = WS_IDX + (size_t)TLAT * 128 * 4;
constexpr size_t WS_SSQ   = WS_GATE + (size_t)TLAT * 128 * 4;
constexpr size_t WS_CPART = WS_SSQ + (size_t)TLAT * 32 * 4;
constexpr size_t WS_CQ    = WS_CPART + (size_t)16 * 2 * 2048 * 4;
constexpr size_t WS_SKH   = WS_CQ + (size_t)2 * 2048 * 4;
constexpr size_t WS_S8    = WS_SKH + (size_t)2 * 8 * 2 * 128 * 128 * 2;
constexpr float  S8_SCALE = 0.25f;
constexpr size_t WS_END   = WS_S8 + (size_t)16 * GL_NS * 32768;

struct Params {
    const float* in[N_IN];
    float* out;
    unsigned char* ws;
};

__device__ __forceinline__ float bf2f(unsigned short b) { return __uint_as_float(((unsigned)b) << 16); }
__device__ __forceinline__ float bflo(unsigned u) { return __uint_as_float(u << 16); }
__device__ __forceinline__ float bfhi(unsigned u) { return __uint_as_float(u & 0xffff0000u); }
typedef __bf16 bf16x2v_t __attribute__((ext_vector_type(2)));
typedef float f32x2v_t __attribute__((ext_vector_type(2)));
__device__ __forceinline__ unsigned pack2(float lo, float hi) { f32x2v_t f; f[0] = lo; f[1] = hi; return __builtin_bit_cast(unsigned, __builtin_convertvector(f, bf16x2v_t)); }
__device__ __forceinline__ unsigned short f2bf(float f) { return (unsigned short)(pack2(f, 0.f) & 0xffffu); }
__device__ __forceinline__ float wave_sum(float v) {
#pragma unroll
    for (int o = 32; o >= 1; o >>= 1) v += __shfl_xor(v, o);
    return v;
}
__device__ __forceinline__ float wave_max(float v) {
#pragma unroll
    for (int o = 32; o >= 1; o >>= 1) v = fmaxf(v, __shfl_xor(v, o));
    return v;
}
__device__ __forceinline__ float gelu_exact(float x) { return 0.5f * x * (1.0f + erff(x * 0.70710678118654752f)); }
__device__ __forceinline__ float silu_f(float x) { return x * __builtin_amdgcn_rcpf(1.0f + __expf(-x)); }
__device__ __forceinline__ float dot2bf(unsigned a, unsigned b, float c) { return __builtin_amdgcn_fdot2_f32_bf16(__builtin_bit_cast(bf16x2_t, a), __builtin_bit_cast(bf16x2_t, b), c, false); }
__device__ __forceinline__ void wave_lds_fence() { asm volatile("s_waitcnt lgkmcnt(0)" ::: "memory"); __builtin_amdgcn_wave_barrier(); }

constexpr int MOD_KS = 32;
__device__ void st_mod_partial(const Params& p, int bid, int nb) {
    const int lane = threadIdx.x & 63, wv = __builtin_amdgcn_readfirstlane(threadIdx.x >> 6);
    float* part = (float*)(p.ws + WS_MPART);
    const float* wm = p.in[I_WMOD];
    for (int it = bid * 8 + wv; it < MOD_KS * 48; it += nb * 8) {
        const int ks = it / 48, cc = it - ks * 48;
        const int k0 = ks * 64, n0 = cc * 256 + lane * 4;
        float4 a0 = {0.f, 0.f, 0.f, 0.f}, a1 = a0, a2 = a0;
        const int k = k0 + lane;
        const float s0 = silu_f(p.in[I_C][k]), s1 = silu_f(p.in[I_C][DM + k]), s2 = silu_f(p.in[I_CCTX][k]);
        const float* wrow = wm + (size_t)k0 * 12288 + n0;
#pragma unroll 16
        for (int j = 0; j < 64; ++j) {
            const float4 w = *(const float4*)(wrow + (size_t)j * 12288);
            const float t0 = __shfl(s0, j), t1 = __shfl(s1, j), t2 = __shfl(s2, j);
            a0.x += t0 * w.x; a0.y += t0 * w.y; a0.z += t0 * w.z; a0.w += t0 * w.w;
            a1.x += t1 * w.x; a1.y += t1 * w.y; a1.z += t1 * w.z; a1.w += t1 * w.w;
            a2.x += t2 * w.x; a2.y += t2 * w.y; a2.z += t2 * w.z; a2.w += t2 * w.w;
        }
        *(float4*)(part + (size_t)(ks * 3 + 0) * 12288 + n0) = a0;
        *(float4*)(part + (size_t)(ks * 3 + 1) * 12288 + n0) = a1;
        *(float4*)(part + (size_t)(ks * 3 + 2) * 12288 + n0) = a2;
    }
}

__device__ void st_mod_direct(const Params& p, int bid, int nb, unsigned char* smem) {
    float* sv = (float*)smem;
    float* red = sv + 3 * DM;
    const int tid = threadIdx.x;
    for (int i = tid; i < DM; i += NTHR) { sv[i] = silu_f(p.in[I_C][i]); sv[DM + i] = silu_f(p.in[I_C][DM + i]); sv[2 * DM + i] = silu_f(p.in[I_CCTX][i]); }
    __syncthreads();
    float* M = (float*)(p.ws + WS_M);
    const int rr = tid / 12, c4 = tid - rr * 12;
    for (int cb = bid; cb < 256; cb += nb) {
        if (tid < 504) {
            float4 a0 = make_float4(0.f, 0.f, 0.f, 0.f), a1 = a0, a2 = a0;
            const float* wp = p.in[I_WMOD] + cb * 48 + c4 * 4;
#pragma unroll 7
            for (int k = rr; k < DM; k += 42) {
                const float4 w = *(const float4*)(wp + (size_t)k * 12288);
                const float s0 = sv[k], s1 = sv[DM + k], s2 = sv[2 * DM + k];
                a0.x += s0 * w.x; a0.y += s0 * w.y; a0.z += s0 * w.z; a0.w += s0 * w.w;
                a1.x += s1 * w.x; a1.y += s1 * w.y; a1.z += s1 * w.z; a1.w += s1 * w.w;
                a2.x += s2 * w.x; a2.y += s2 * w.y; a2.z += s2 * w.z; a2.w += s2 * w.w;
            }
            *(float4*)(red + (rr * 3 + 0) * 48 + c4 * 4) = a0; *(float4*)(red + (rr * 3 + 1) * 48 + c4 * 4) = a1; *(float4*)(red + (rr * 3 + 2) * 48 + c4 * 4) = a2;
        }
        __syncthreads();
        if (tid < 144) {
            const int v = tid / 48, c = tid - v * 48;
            float sum = p.in[I_BMOD][cb * 48 + c];
#pragma unroll
            for (int q = 0; q < 42; ++q) sum += red[(q * 3 + v) * 48 + c];
            M[(size_t)v * 12288 + cb * 48 + c] = sum;
        }
        __syncthreads();
    }
}

__device__ void st_skey_split(const Params& p, int bid, int nb) {
    unsigned short* SKH = (unsigned short*)(p.ws + WS_SKH);
    for (int i = bid * NTHR + threadIdx.x; i < 2 * 8 * 128 * 32; i += nb * NTHR) {
        const int hh8 = i >> 12, k = (i >> 5) & 127, d4 = i & 31;
        const float4 w = *(const float4*)(p.in[I_SK] + ((size_t)hh8 * 128 + k) * 128 + d4 * 4);
        const unsigned short h0 = f2bf(w.x), h1 = f2bf(w.y), h2 = f2bf(w.z), h3 = f2bf(w.w);
        uint2 hi2, lo2;
        hi2.x = (unsigned)h0 | ((unsigned)h1 << 16); hi2.y = (unsigned)h2 | ((unsigned)h3 << 16);
        lo2.x = pack2(w.x - bf2f(h0), w.y - bf2f(h1)); lo2.y = pack2(w.z - bf2f(h2), w.w - bf2f(h3));
        *(uint2*)(SKH + ((size_t)(hh8 * 2 + 0) * 128 + k) * 128 + d4 * 4) = hi2;
        *(uint2*)(SKH + ((size_t)(hh8 * 2 + 1) * 128 + k) * 128 + d4 * 4) = lo2;
    }
}
__device__ void st_mod_final(const Params& p, int bid, int nb) {
    const float* part = (const float*)(p.ws + WS_MPART);
    float* M = (float*)(p.ws + WS_M);
    for (int i = bid * NTHR + threadIdx.x; i < 3 * 12288; i += nb * NTHR) {
        const int r = i / 12288, n = i - r * 12288;
        float s = p.in[I_BMOD][n];
#pragma unroll
        for (int ks = 0; ks < MOD_KS; ++ks) s += part[(size_t)(ks * 3 + r) * 12288 + n];
        M[i] = s;
    }
}

struct WprepItem { const float* W; int ldw; bf16_t* Bt; int kt, nt, mode; };
__device__ __forceinline__ WprepItem wprep_item(const Params& p, int it) {
    WprepItem w;
    if (it < 1344) { w.W = p.in[I_WIN]; w.ldw = 5152; w.Bt = (bf16_t*)(p.ws + WS_BT1); w.kt = it & 15; w.nt = it >> 4; w.mode = 1; }
    else { const int j = it - 1344; w.W = p.in[I_WOUT]; w.ldw = DM; w.Bt = (bf16_t*)(p.ws + WS_BT2); w.kt = j & 15; w.nt = j >> 4; w.mode = 0; }
    return w;
}
__device__ __forceinline__ void wprep_load(const WprepItem& w, float4 (&v)[4]) {
    const int tid = threadIdx.x, r = tid >> 4, c4 = tid & 15;
    const int nd = w.nt * 64 + c4 * 4;
    int sc = nd; bool valid = true;
    if (w.mode == 1) { if (nd < 3072) sc = nd; else if (nd < 5120) sc = nd + 32; else if (nd < 5152) sc = 3072 + (nd - 5120); else { sc = 0; valid = false; } }
#pragma unroll
    for (int i = 0; i < 4; ++i) {
        v[i] = make_float4(0.f, 0.f, 0.f, 0.f);
        if (valid) v[i] = *(const float4*)(w.W + (size_t)(w.kt * 128 + r + 32 * i) * w.ldw + sc);
    }
}
__device__ void st_wprep(const Params& p, int bid, int nb, unsigned char* smem) {
    unsigned short* tl = (unsigned short*)smem;
    const int tid = threadIdx.x, r = tid >> 4, c4 = tid & 15;
    const int NIT = 1344 + 512;
    float4 v[4];
    int it = bid;
    if (it < NIT) wprep_load(wprep_item(p, it), v);
    for (; it < NIT; it += nb) {
        const WprepItem w = wprep_item(p, it);
#pragma unroll
        for (int i = 0; i < 4; ++i) {
            const int kl = r + 32 * i;
            tl[(c4 * 4 + 0) * 136 + kl] = f2bf(v[i].x); tl[(c4 * 4 + 1) * 136 + kl] = f2bf(v[i].y);
            tl[(c4 * 4 + 2) * 136 + kl] = f2bf(v[i].z); tl[(c4 * 4 + 3) * 136 + kl] = f2bf(v[i].w);
        }
        __syncthreads();
        if (it + nb < NIT) wprep_load(wprep_item(p, it + nb), v);
        {
            const int n = tid >> 3, seg = tid & 7;
            const uint4* src = (const uint4*)(tl + n * 136 + seg * 16);
            const uint4 v0 = src[0], v1 = src[1];
            uint4* dst = (uint4*)(w.Bt + (size_t)(w.nt * 64 + n) * DM + w.kt * 128 + seg * 16);
            dst[0] = v0; dst[1] = v1;
        }
        __syncthreads();
    }
}

__device__ void st_wprep_q(const Params& p, int bid, int nb, unsigned char* smem) {
    unsigned short* tl = (unsigned short*)smem;
    float* red = (float*)(smem + 2 * 64 * 136 * 2);
    const int tid = threadIdx.x, r = tid >> 4, c4 = tid & 15;
    const float* M = (const float*)(p.ws + WS_M);
    float* CP = (float*)(p.ws + WS_CPART);
    bf16_t* Bt = (bf16_t*)(p.ws + WS_BT3);
    for (int it = bid; it < 512; it += nb) {
        const int kt = it & 15, nt = it >> 4;
        float4 v[4]; float gs[2][4], sh[2][4];
#pragma unroll
        for (int i = 0; i < 4; ++i) {
            const int k = kt * 128 + r + 32 * i;
            v[i] = *(const float4*)(p.in[I_WQ] + (size_t)k * DM + nt * 64 + c4 * 4);
            const float g = p.in[I_N2G][k];
#pragma unroll
            for (int b = 0; b < 2; ++b) { gs[b][i] = g * (1.0f + M[(size_t)b * 12288 + 4 * DM + k]); sh[b][i] = M[(size_t)b * 12288 + 3 * DM + k]; }
        }
#pragma unroll
        for (int b = 0; b < 2; ++b) {
            float4 pc = make_float4(0.f, 0.f, 0.f, 0.f);
#pragma unroll
            for (int i = 0; i < 4; ++i) {
                const int kl = r + 32 * i;
                unsigned short* t0 = tl + b * (64 * 136) + (c4 * 4) * 136 + kl;
                t0[0] = f2bf(v[i].x * gs[b][i]); t0[136] = f2bf(v[i].y * gs[b][i]); t0[2 * 136] = f2bf(v[i].z * gs[b][i]); t0[3 * 136] = f2bf(v[i].w * gs[b][i]);
                pc.x += sh[b][i] * v[i].x; pc.y += sh[b][i] * v[i].y; pc.z += sh[b][i] * v[i].z; pc.w += sh[b][i] * v[i].w;
            }
            *(float4*)(red + (b * 32 + r) * 64 + c4 * 4) = pc;
        }
        __syncthreads();
        {
            const int n = tid >> 3, seg = tid & 7;
#pragma unroll
            for (int b = 0; b < 2; ++b) {
                const uint4* src = (const uint4*)(tl + b * (64 * 136) + n * 136 + seg * 16);
                const uint4 v0 = src[0], v1 = src[1];
                uint4* dst = (uint4*)(Bt + (size_t)(b * DM + nt * 64 + n) * DM + kt * 128 + seg * 16);
                dst[0] = v0; dst[1] = v1;
            }
            if (tid < 128) {
                const int b = tid >> 6, col = tid & 63;
                float sum = 0.f;
#pragma unroll
                for (int rr = 0; rr < 32; ++rr) sum += red[(b * 32 + rr) * 64 + col];
                CP[(size_t)(kt * 2 + b) * DM + nt * 64 + col] = sum;
            }
        }
        __syncthreads();
    }
}
__device__ void st_cq_final(const Params& p, int bid) {
    const int i = bid * NTHR + threadIdx.x;
    if (i < 2 * DM) {
        const float* CP = (const float*)(p.ws + WS_CPART);
        const int b = i >> 11, n = i & (DM - 1);
        float sum = 0.f;
#pragma unroll
        for (int kt = 0; kt < 16; ++kt) sum += CP[(size_t)(kt * 2 + b) * DM + n];
        ((float*)(p.ws + WS_CQ))[i] = sum;
    }
}
typedef float f32x2_t __attribute__((ext_vector_type(2)));
typedef float v16f_t __attribute__((ext_vector_type(16)));
typedef float v32f_t __attribute__((ext_vector_type(32)));
typedef unsigned v6u_t __attribute__((ext_vector_type(6)));
__device__ void st_econv(const Params& p, int bid, int nb) {
    const int lane = threadIdx.x & 63, wv = __builtin_amdgcn_readfirstlane(threadIdx.x >> 6);
    float* esc = (float*)(p.ws + WS_ESC);
    float4 nx[8];
    {
        const int row0 = bid * 8 + wv;
        const float* src0 = ((row0 >> 14) ? p.in[I_PV] : p.in[I_PU]) + (size_t)(row0 & 16383) * DM + lane * 4;
#pragma unroll
        for (int q = 0; q < 8; ++q) nx[q] = row0 < 2 * 16384 ? *(const float4*)(src0 + q * 256) : make_float4(0.f, 0.f, 0.f, 0.f);
    }
    for (int row = bid * 8 + wv; row < 2 * 16384; row += nb * 8) {
        const int tbl = row >> 14, r = row & 16383;
        float x[32];
        float m = 0.f;
#pragma unroll
        for (int q = 0; q < 8; ++q) {
            const float4 a = nx[q];
            x[q * 4 + 0] = a.x; x[q * 4 + 1] = a.y; x[q * 4 + 2] = a.z; x[q * 4 + 3] = a.w;
            m = fmaxf(m, fmaxf(fmaxf(fabsf(a.x), fabsf(a.y)), fmaxf(fabsf(a.z), fabsf(a.w))));
        }
        {
            const int rown = row + nb * 8;
            if (rown < 2 * 16384) {
                const float* srcn = ((rown >> 14) ? p.in[I_PV] : p.in[I_PU]) + (size_t)(rown & 16383) * DM + lane * 4;
#pragma unroll
                for (int q = 0; q < 8; ++q) nx[q] = *(const float4*)(srcn + q * 256);
            }
        }
        m = wave_max(m);
        if (PEER_NHI > 0) {
        const float sc = m > 0.f ? 7.5f / m : 1.0f;
        if (lane == 0) esc[tbl * 16384 + r] = m > 0.f ? m / 7.5f : 1.0f;
        v16f_t va, vb;
#pragma unroll
        for (int i = 0; i < 16; ++i) { va[i] = x[2 * i] * sc; vb[i] = x[2 * i + 1] * sc; }
        const v6u_t pk = __builtin_amdgcn_cvt_scalef32_2xpk16_fp6_f32(va, vb, 1.0f);
        unsigned char* dst = p.ws + (tbl ? WS_EV : WS_EU) + (size_t)r * EROW;
        uint4 o; o.x = pk[0]; o.y = pk[1]; o.z = pk[2]; o.w = pk[3];
        uint2 o2; o2.x = pk[4]; o2.y = pk[5];
        *(uint4*)(dst + lane * 16) = o;
        *(uint2*)(dst + 1024 + lane * 8) = o2;
        }
        unsigned w4[4] = {0u, 0u, 0u, 0u};
        float best = 3.0e38f, bscale = 1.0f;
#pragma unroll
        for (int ci = 0; ci < 4; ++ci) {
            const float cr = 1.0f - 0.125f * ci;
            const float inv4 = m > 0.f ? (cr * m) / 6.0f : 1.0f, sc4 = 1.0f / inv4;
            unsigned wc[4]; float err = 0.f;
#pragma unroll
            for (int q = 0; q < 4; ++q) {
                unsigned wq = 0u;
                wq = __builtin_amdgcn_cvt_scalef32_pk_fp4_f32(wq, x[q * 8 + 0] * sc4, x[q * 8 + 1] * sc4, 1.0f, 0);
                wq = __builtin_amdgcn_cvt_scalef32_pk_fp4_f32(wq, x[q * 8 + 2] * sc4, x[q * 8 + 3] * sc4, 1.0f, 1);
                wq = __builtin_amdgcn_cvt_scalef32_pk_fp4_f32(wq, x[q * 8 + 4] * sc4, x[q * 8 + 5] * sc4, 1.0f, 2);
                wq = __builtin_amdgcn_cvt_scalef32_pk_fp4_f32(wq, x[q * 8 + 6] * sc4, x[q * 8 + 7] * sc4, 1.0f, 3);
                wc[q] = wq;
                const f32x2_t d0 = __builtin_amdgcn_cvt_scalef32_pk_f32_fp4(wq, 1.0f, 0), d1 = __builtin_amdgcn_cvt_scalef32_pk_f32_fp4(wq, 1.0f, 1);
                const f32x2_t d2 = __builtin_amdgcn_cvt_scalef32_pk_f32_fp4(wq, 1.0f, 2), d3 = __builtin_amdgcn_cvt_scalef32_pk_f32_fp4(wq, 1.0f, 3);
                float e;
                e = x[q * 8 + 0] - d0[0] * inv4; err += e * e; e = x[q * 8 + 1] - d0[1] * inv4; err += e * e;
                e = x[q * 8 + 2] - d1[0] * inv4; err += e * e; e = x[q * 8 + 3] - d1[1] * inv4; err += e * e;
                e = x[q * 8 + 4] - d2[0] * inv4; err += e * e; e = x[q * 8 + 5] - d2[1] * inv4; err += e * e;
                e = x[q * 8 + 6] - d3[0] * inv4; err += e * e; e = x[q * 8 + 7] - d3[1] * inv4; err += e * e;
            }
            err = wave_sum(err);
            if (err < best) { best = err; bscale = inv4; w4[0] = wc[0]; w4[1] = wc[1]; w4[2] = wc[2]; w4[3] = wc[3]; }
        }
        if (lane == 0) esc[(2 + tbl) * 16384 + r] = bscale;
        uint4 o4; o4.x = w4[0]; o4.y = w4[1]; o4.z = w4[2]; o4.w = w4[3];
        *(uint4*)(p.ws + (tbl ? WS_EV4 : WS_EU4) + (size_t)r * EROW4 + lane * 16) = o4;
    }
}

__device__ void st_normmod(const Params& p, const float* src_lat, const float* src_ctx, int nrows, const float* gvec, int sh_off, int sc_off, int bid, int nb, const bf16_t* src_bf16 = nullptr) {
    const int lane = threadIdx.x & 63, wv = __builtin_amdgcn_readfirstlane(threadIdx.x >> 6);
    const float* M = (const float*)(p.ws + WS_M);
    bf16_t* A = (bf16_t*)(p.ws + WS_A);
    float4 nx[8];
    {
        const int row0 = bid * 8 + wv;
        const float* src0 = row0 < TLAT ? src_lat + (size_t)row0 * DM : src_ctx + (size_t)(row0 - TLAT) * DM;
#pragma unroll
        for (int i = 0; i < 4; ++i) { nx[2 * i] = row0 < nrows ? *(const float4*)(src0 + i * 512 + lane * 8) : make_float4(0.f, 0.f, 0.f, 0.f); nx[2 * i + 1] = row0 < nrows ? *(const float4*)(src0 + i * 512 + lane * 8 + 4) : make_float4(0.f, 0.f, 0.f, 0.f); }
    }
    for (int row = bid * 8 + wv; row < nrows; row += nb * 8) {
        const int mrow = row < TLAT ? (row >> 14) : 2;
        float v[32];
        float ss = 0.f;
#pragma unroll
        for (int i = 0; i < 4; ++i) {
            const float4 a = nx[2 * i], b = nx[2 * i + 1];
            v[i * 8 + 0] = a.x; v[i * 8 + 1] = a.y; v[i * 8 + 2] = a.z; v[i * 8 + 3] = a.w;
            v[i * 8 + 4] = b.x; v[i * 8 + 5] = b.y; v[i * 8 + 6] = b.z; v[i * 8 + 7] = b.w;
        }
        {
            const int rown = row + nb * 8;
            if (rown < nrows) {
                const float* srcn = rown < TLAT ? src_lat + (size_t)rown * DM : src_ctx + (size_t)(rown - TLAT) * DM;
#pragma unroll
                for (int i = 0; i < 4; ++i) { nx[2 * i] = *(const float4*)(srcn + i * 512 + lane * 8); nx[2 * i + 1] = *(const float4*)(srcn + i * 512 + lane * 8 + 4); }
            }
        }
#pragma unroll
        for (int j = 0; j < 32; ++j) ss += v[j] * v[j];
        ss = wave_sum(ss);
        const float rstd = rsqrtf(ss * (1.0f / DM) + EPS);
        const float* mp = M + (size_t)mrow * 12288;
        uint4 wout[4];
#pragma unroll
        for (int i = 0; i < 4; ++i) {
            const int c0 = i * 512 + lane * 8;
            float o[8];
#pragma unroll
            for (int hh = 0; hh < 2; ++hh) {
                const float4 g = *(const float4*)(gvec + c0 + hh * 4), sc = *(const float4*)(mp + sc_off + c0 + hh * 4), sh = *(const float4*)(mp + sh_off + c0 + hh * 4);
                o[hh * 4 + 0] = v[i * 8 + hh * 4 + 0] * rstd * g.x * (1.f + sc.x) + sh.x;
                o[hh * 4 + 1] = v[i * 8 + hh * 4 + 1] * rstd * g.y * (1.f + sc.y) + sh.y;
                o[hh * 4 + 2] = v[i * 8 + hh * 4 + 2] * rstd * g.z * (1.f + sc.z) + sh.z;
                o[hh * 4 + 3] = v[i * 8 + hh * 4 + 3] * rstd * g.w * (1.f + sc.w) + sh.w;
            }
            wout[i].x = pack2(o[0], o[1]); wout[i].y = pack2(o[2], o[3]); wout[i].z = pack2(o[4], o[5]); wout[i].w = pack2(o[6], o[7]);
        }
#pragma unroll
        for (int i = 0; i < 4; ++i) *(uint4*)(A + (size_t)row * DM + i * 512 + lane * 8) = wout[i];
    }
}

struct EpiP {
    static constexpr bool PERM = true, AFTER_DRAIN = false;
    bf16_t* O; int ldc;
    __device__ __forceinline__ int btile(const pg8::Unit& u) const { return u.pn; }
    __device__ __forceinline__ void operator()(const pg8::f32x4 (&acc)[2][2][4][2], const pg8::Unit& u, int wr, int wc, int fr, int fq) const {
        using namespace pg8;
        const int row0 = u.pm * BM + wr * 64 + fr; const int col0 = u.pn * BM + wc * 32 + 8 * fq;
        const bool act = (u.pn >= 12) && (u.pn < 20);
#pragma unroll
        for (int ai = 0; ai < 2; ++ai)
#pragma unroll
            for (int m = 0; m < 4; ++m) { bf16_t* rowp = O + (size_t)(row0 + ai * HALF + m * 16) * ldc + col0;
#pragma unroll
                for (int bj = 0; bj < 2; ++bj) { f32x4 v0 = acc[ai][bj][m][0], v1 = acc[ai][bj][m][1];
                    if (act) { f32x2 a = gelu_pk((f32x2){v0[0], v0[1]}), b = gelu_pk((f32x2){v0[2], v0[3]}), c = gelu_pk((f32x2){v1[0], v1[1]}), d = gelu_pk((f32x2){v1[2], v1[3]});
                        v0 = (f32x4){a.x, a.y, b.x, b.y}; v1 = (f32x4){c.x, c.y, d.x, d.y}; }
                    u32x4 w; w.x = cvt_pk_bf16(v0[0], v0[1]); w.y = cvt_pk_bf16(v0[2], v0[3]); w.z = cvt_pk_bf16(v1[0], v1[1]); w.w = cvt_pk_bf16(v1[2], v1[3]);
                    *(u32x4*)(rowp + bj * HALF) = w; } }
    }
};
struct EpiQ {
    static constexpr bool PERM = true, AFTER_DRAIN = false;
    bf16_t* O; const float* SSQ; const float* CQ;
    __device__ __forceinline__ int btile(const pg8::Unit& u) const { return u.pn + (u.pm >= 64 ? 8 : 0); }
    __device__ __forceinline__ void operator()(const pg8::f32x4 (&acc)[2][2][4][2], const pg8::Unit& u, int wr, int wc, int fr, int fq) const {
        using namespace pg8;
        const int row0 = u.pm * BM + wr * 64 + fr, col0 = u.pn * BM + wc * 32 + 8 * fq;
        const float* cq = CQ + (size_t)(u.pm >= 64 ? 1 : 0) * DM + col0;
        f32x4 cv[2][2];
#pragma unroll
        for (int bj = 0; bj < 2; ++bj)
#pragma unroll
            for (int n = 0; n < 2; ++n) cv[bj][n] = *(const f32x4*)(cq + bj * HALF + 4 * n);
        float rs[2][4];
#pragma unroll
        for (int ai = 0; ai < 2; ++ai)
#pragma unroll
            for (int m = 0; m < 4; ++m) {
                const float* sp = SSQ + (size_t)(row0 + ai * HALF + m * 16) * 32 + fq * 8;
                const f32x4 a = *(const f32x4*)sp, b = *(const f32x4*)(sp + 4);
                float t = (a[0] + a[1]) + (a[2] + a[3]) + (b[0] + b[1]) + (b[2] + b[3]);
                t += __shfl_xor(t, 16); t += __shfl_xor(t, 32);
                rs[ai][m] = rsqrtf(t * (1.0f / DM) + EPS);
            }
#pragma unroll
        for (int ai = 0; ai < 2; ++ai)
#pragma unroll
            for (int m = 0; m < 4; ++m) { bf16_t* rowp = O + (size_t)(row0 + ai * HALF + m * 16) * DM + col0;
#pragma unroll
                for (int bj = 0; bj < 2; ++bj) { const f32x4 v0 = acc[ai][bj][m][0] * rs[ai][m] + cv[bj][0], v1 = acc[ai][bj][m][1] * rs[ai][m] + cv[bj][1];
                    u32x4 w; w.x = cvt_pk_bf16(v0[0], v0[1]); w.y = cvt_pk_bf16(v0[2], v0[3]); w.z = cvt_pk_bf16(v1[0], v1[1]); w.w = cvt_pk_bf16(v1[2], v1[3]);
                    *(u32x4*)(rowp + bj * HALF) = w; } }
    }
};
struct EpiH1 {
    static constexpr bool PERM = true, AFTER_DRAIN = false;
    bf16_t* C; const float* X; const float* Mv; float* SSQ;
    __device__ __forceinline__ int btile(const pg8::Unit& u) const { return u.pn; }
    __device__ __forceinline__ void operator()(const pg8::f32x4 (&acc)[2][2][4][2], const pg8::Unit& u, int wr, int wc, int fr, int fq) const {
        using namespace pg8;
        const int row0 = u.pm * BM + wr * 64 + fr, col0 = u.pn * BM + wc * 32 + 8 * fq;
        const float* g1 = Mv + (size_t)(u.pm >= 64 ? 1 : 0) * 12288 + 2 * DM;
        f32x4 gv[2][2];
#pragma unroll
        for (int bj = 0; bj < 2; ++bj)
#pragma unroll
            for (int n = 0; n < 2; ++n) gv[bj][n] = *(const f32x4*)(g1 + col0 + bj * HALF + 4 * n);
#pragma unroll
        for (int ai = 0; ai < 2; ++ai) {
            f32x4 xv[4][2][2];
#pragma unroll
            for (int m = 0; m < 4; ++m)
#pragma unroll
                for (int bj = 0; bj < 2; ++bj)
#pragma unroll
                    for (int n = 0; n < 2; ++n) xv[m][bj][n] = *(const f32x4*)(X + (size_t)(row0 + ai * HALF + m * 16) * DM + col0 + bj * HALF + 4 * n);
#pragma unroll
            for (int m = 0; m < 4; ++m) {
                float ssq = 0.f;
#pragma unroll
                for (int bj = 0; bj < 2; ++bj) {
                    const f32x4 v0 = xv[m][bj][0] + gv[bj][0] * acc[ai][bj][m][0], v1 = xv[m][bj][1] + gv[bj][1] * acc[ai][bj][m][1];
                    ssq += (v0[0] * v0[0] + v0[1] * v0[1]) + (v0[2] * v0[2] + v0[3] * v0[3]) + (v1[0] * v1[0] + v1[1] * v1[1]) + (v1[2] * v1[2] + v1[3] * v1[3]);
                    u32x4 w; w.x = cvt_pk_bf16(v0[0], v0[1]); w.y = cvt_pk_bf16(v0[2], v0[3]); w.z = cvt_pk_bf16(v1[0], v1[1]); w.w = cvt_pk_bf16(v1[2], v1[3]);
                    *(u32x4*)(C + (size_t)(row0 + ai * HALF + m * 16) * DM + col0 + bj * HALF) = w;
                }
                ssq += __shfl_xor(ssq, 16); ssq += __shfl_xor(ssq, 32);
                if (fq == 0) SSQ[(size_t)(row0 + ai * HALF + m * 16) * 32 + u.pn * 4 + wc] = ssq;
            }
        }
    }
};

typedef short bf16x8_t __attribute__((ext_vector_type(8)));
typedef short s16x4_t __attribute__((ext_vector_type(4)));
typedef float f32x4_t __attribute__((ext_vector_type(4)));
typedef float f32x16_t __attribute__((ext_vector_type(16)));
#define LDSP(T, off) ((__attribute__((address_space(3))) T*)(lds3 + (off)))
constexpr int GL_RAWQ = 0, GL_RAWK = 16384, GL_LR = 32768, GL_V = 40960, GL_X = 77824, GL_TOT = 147456, GL_SS = 149504;
constexpr int GL_P = GL_RAWQ, GL_OBUF = GL_X;
constexpr int GL_VS = 288;
constexpr int GL_XS = 136;
constexpr int GL_KS = 72;
constexpr float GL_QSCALE = 0.08838834764831845f;

typedef unsigned u32x4_t __attribute__((ext_vector_type(4)));
typedef unsigned u32x2_t __attribute__((ext_vector_type(2)));
struct GlaRaw { u32x4_t q0, q1, k0, k1, v0, v1, v2, v3; u32x2_t lr; float w0, w1, w2, w3, w4, w5, w6, w7; float bg; };
template <bool NEED_Q>
__device__ __forceinline__ void gla_fetch(const Params& p, GlaRaw& R, size_t row0, int h) {
    const int tid = threadIdx.x;
    const bf16_t* P = (const bf16_t*)(p.ws + WS_P);
    const int j = tid >> 3, part = tid & 7;
    const bf16_t* pr = P + (row0 + j) * NP;
    if (NEED_Q) { const u32x4_t* s4 = (const u32x4_t*)(pr + PC_Q + h * 128 + part * 16); R.q0 = s4[0]; R.q1 = s4[1]; }
    { const u32x4_t* s4 = (const u32x4_t*)(pr + PC_K + h * 128 + part * 16); R.k0 = s4[0]; R.k1 = s4[1]; }
    { const u32x4_t* s4 = (const u32x4_t*)(pr + PC_V + h * 256 + part * 32); R.v0 = s4[0]; R.v1 = s4[1]; R.v2 = s4[2]; R.v3 = s4[3]; }
    R.lr = *(const u32x2_t*)(pr + PC_LR + part * 4);
    const int lane = tid & 63, wv = tid >> 6, dir = wv >> 2, d = (wv & 3) * 32 + (lane & 31), hh = lane >> 5;
    const float* wg = p.in[I_WGU] + (size_t)(dir * 16 + 8 * hh) * 512 + h * 128 + d;
    R.w0 = wg[0]; R.w1 = wg[512]; R.w2 = wg[1024]; R.w3 = wg[1536]; R.w4 = wg[2048]; R.w5 = wg[2560]; R.w6 = wg[3072]; R.w7 = wg[3584];
    R.bg = p.in[I_BG][dir * 512 + h * 128 + d];
}
template <bool NEED_Q>
__device__ __forceinline__ void gla_commit(unsigned char* smem, const GlaRaw& R, uint4& bw, float& bg) {
    const int tid = threadIdx.x, j = tid >> 3, part = tid & 7;
    PG8_LAS unsigned char* lds3 = (PG8_LAS unsigned char*)smem;
    if (NEED_Q) { *LDSP(u32x4_t, GL_RAWQ + (j * 128 + part * 16) * 2) = R.q0; *LDSP(u32x4_t, GL_RAWQ + (j * 128 + part * 16) * 2 + 16) = R.q1; }
    *LDSP(u32x4_t, GL_RAWK + (j * 128 + part * 16) * 2) = R.k0; *LDSP(u32x4_t, GL_RAWK + (j * 128 + part * 16) * 2 + 16) = R.k1;
    { const unsigned vo = GL_V + (j * GL_VS + part * 32) * 2; *LDSP(u32x4_t, vo) = R.v0; *LDSP(u32x4_t, vo + 16) = R.v1; *LDSP(u32x4_t, vo + 32) = R.v2; *LDSP(u32x4_t, vo + 48) = R.v3; }
    *LDSP(u32x2_t, GL_LR + (j * 32 + part * 4) * 2) = R.lr;
    bw.x = pack2(R.w0, R.w1); bw.y = pack2(R.w2, R.w3); bw.z = pack2(R.w4, R.w5); bw.w = pack2(R.w6, R.w7); bg = R.bg;
}
__device__ __forceinline__ void gla_z(unsigned char* smem, const uint4 bw, const float bg) {
    PG8_LAS unsigned char* lds3 = (PG8_LAS unsigned char*)smem;
    const int tid = threadIdx.x, lane = tid & 63, wv = __builtin_amdgcn_readfirstlane(tid >> 6);
    const int dir = wv >> 2, r = lane & 31, hh = lane >> 5, d = (wv & 3) * 32 + r;
    const bf16x8_t bfr = __builtin_bit_cast(bf16x8_t, bw);
#pragma unroll
    for (int mt = 0; mt < 2; ++mt) {
        const bf16x8_t afr = *LDSP(bf16x8_t, GL_LR + ((mt * 32 + r) * 32 + dir * 16 + 8 * hh) * 2);
        f32x16_t acc;
#pragma unroll
        for (int i = 0; i < 16; ++i) acc[i] = 0.f;
        acc = __builtin_amdgcn_mfma_f32_32x32x16_bf16(afr, bfr, acc, 0, 0, 0);
#pragma unroll
        for (int reg = 0; reg < 16; ++reg) {
            const int t = mt * 32 + (reg & 3) + 8 * (reg >> 2) + 4 * hh;
            *LDSP(float, GL_X + ((dir * 64 + t) * 128 + d) * 4) = acc[reg] + bg;
        }
    }
}
template <bool PASS_A>
__device__ __forceinline__ void gla_prep(unsigned char* smem, float* dec_f, float* dec_b) {
    PG8_LAS unsigned char* lds3 = (PG8_LAS unsigned char*)smem;
    const int tid = threadIdx.x, dp = tid & 63, wv = __builtin_amdgcn_readfirstlane(tid >> 6), dir = wv & 1, tq = wv >> 1;
    float la0[16], la1[16];
    {
        unsigned bz = GL_X + ((dir * 64 + tq * 16) * 128 + 2 * dp) * 4; asm volatile("" : "+v"(bz));
#pragma unroll
        for (int tt = 0; tt < 16; ++tt) { const f32x2_t z = *LDSP(f32x2_t, bz + tt * 512); la0[tt] = z[0]; la1[tt] = z[1]; }
    }
#pragma unroll
    for (int tt = 0; tt < 16; ++tt) {
        const float z0 = la0[tt], z1 = la1[tt];
        la0[tt] = (fminf(z0, 0.f) - 0.69314718056f * __builtin_amdgcn_logf(1.0f + __builtin_amdgcn_exp2f(fabsf(z0) * -1.44269504089f))) * (1.0f / 16.0f);
        la1[tt] = (fminf(z1, 0.f) - 0.69314718056f * __builtin_amdgcn_logf(1.0f + __builtin_amdgcn_exp2f(fabsf(z1) * -1.44269504089f))) * (1.0f / 16.0f);
    }
    float run0 = 0.f, run1 = 0.f;
    if (dir == 0) {
#pragma unroll
        for (int tt = 0; tt < 16; ++tt) { run0 += la0[tt]; la0[tt] = run0; run1 += la1[tt]; la1[tt] = run1; }
    } else {
#pragma unroll
        for (int tt = 15; tt >= 0; --tt) { run0 += la0[tt]; la0[tt] = run0; run1 += la1[tt]; la1[tt] = run1; }
    }
    { f32x2_t rr; rr[0] = run0; rr[1] = run1; *LDSP(f32x2_t, GL_TOT + ((tq * 2 + dir) * 128 + 2 * dp) * 4) = rr; }
    __syncthreads();
    float tot0 = 0.f, tot1 = 0.f, off0 = 0.f, off1 = 0.f;
#pragma unroll
    for (int q = 0; q < 4; ++q) {
        const f32x2_t tv = *LDSP(f32x2_t, GL_TOT + ((q * 2 + dir) * 128 + 2 * dp) * 4);
        tot0 += tv[0]; tot1 += tv[1];
        if (dir == 0 ? (q < tq) : (q > tq)) { off0 += tv[0]; off1 += tv[1]; }
    }
    if (PASS_A) {
        if (tq == 0) { float2 dv; dv.x = __expf(tot0); dv.y = __expf(tot1); *(float2*)((dir ? dec_b : dec_f) + 2 * dp) = dv; }
        unsigned w0[8], w1[8];
        unsigned bk = GL_RAWK + ((tq * 16) * 128 + 2 * dp) * 2; asm volatile("" : "+v"(bk));
#pragma unroll
        for (int t2 = 0; t2 < 8; ++t2) {
            const unsigned ka = *LDSP(unsigned, bk + (2 * t2) * 256), kb = *LDSP(unsigned, bk + (2 * t2 + 1) * 256);
            const float ca0 = tot0 - (la0[2 * t2] + off0), ca1 = tot1 - (la1[2 * t2] + off1), cb0 = tot0 - (la0[2 * t2 + 1] + off0), cb1 = tot1 - (la1[2 * t2 + 1] + off1);
            w0[t2] = pack2(bflo(ka) * __expf(ca0), bflo(kb) * __expf(cb0));
            w1[t2] = pack2(bfhi(ka) * __expf(ca1), bfhi(kb) * __expf(cb1));
        }
        const int slot0 = (dp & 1) * 64 + (dp >> 1);
        const unsigned bo = GL_X + dir * (128 * GL_KS * 2) + (slot0 * GL_KS + tq * 16) * 2;
        *LDSP(u32x4_t, bo) = (u32x4_t){w0[0], w0[1], w0[2], w0[3]}; *LDSP(u32x4_t, bo + 16) = (u32x4_t){w0[4], w0[5], w0[6], w0[7]};
        *LDSP(u32x4_t, bo + 32 * GL_KS * 2) = (u32x4_t){w1[0], w1[1], w1[2], w1[3]}; *LDSP(u32x4_t, bo + 32 * GL_KS * 2 + 16) = (u32x4_t){w1[4], w1[5], w1[6], w1[7]};
    } else {
        unsigned bq = GL_RAWQ + ((tq * 16) * 128 + 2 * dp) * 2; asm volatile("" : "+v"(bq));
        unsigned bx = GL_X + dir * (2 * 64 * GL_XS * 2) + ((tq * 16) * GL_XS + 2 * dp) * 2; asm volatile("" : "+v"(bx));
        unsigned qq[16], kk[16];
#pragma unroll
        for (int tt = 0; tt < 16; ++tt) { qq[tt] = *LDSP(unsigned, bq + tt * 256); kk[tt] = *LDSP(unsigned, bq + (GL_RAWK - GL_RAWQ) + tt * 256); }
#pragma unroll
        for (int tt = 0; tt < 16; ++tt) {
            const float c0 = la0[tt] + off0, c1 = la1[tt] + off1;
            *LDSP(unsigned, bx + tt * (GL_XS * 2)) = pack2(bflo(qq[tt]) * (GL_QSCALE * __expf(c0)), bfhi(qq[tt]) * (GL_QSCALE * __expf(c1)));
            *LDSP(unsigned, bx + 64 * GL_XS * 2 + tt * (GL_XS * 2)) = pack2(bflo(kk[tt]) * __expf(-c0), bfhi(kk[tt]) * __expf(-c1));
        }
    }
}
__device__ __forceinline__ bf16x8_t gla_vt_frag(PG8_LAS unsigned char* lds3, int e0, int ks, int lane) {
    const int g = lane >> 4, li = lane & 15, q = li >> 2, pp = li & 3;
    unsigned bv = GL_V + ((8 * (g >> 1) + q) * GL_VS + e0 + 16 * (g & 1) + 4 * pp) * 2; asm volatile("" : "+v"(bv));
    const s16x4_t lo = __builtin_amdgcn_ds_read_tr16_b64_v4i16(LDSP(s16x4_t, bv + ks * (16 * GL_VS * 2)));
    const s16x4_t hi = __builtin_amdgcn_ds_read_tr16_b64_v4i16(LDSP(s16x4_t, bv + ks * (16 * GL_VS * 2) + 4 * GL_VS * 2));
    return __builtin_shufflevector(lo, hi, 0, 1, 2, 3, 4, 5, 6, 7);
}
struct GlaItem { int b, h, c, isctx; size_t row0; int sf, sb; };
__device__ __forceinline__ GlaItem gla_item(int item) {
    GlaItem it;
    if (item < 2048) { it.isctx = 0; it.b = item >> 10; it.h = (item >> 8) & 3; it.c = item & 255; it.row0 = (size_t)it.b * SEQ + it.c * 64; it.sf = 4 + it.c; it.sb = 4 + (255 - it.c); }
    else { const int j = item - 2048; it.isctx = 1; it.b = j >> 4; it.h = (j >> 2) & 3; it.c = j & 3; it.row0 = (size_t)TLAT + it.b * CTXL + it.c * 64; it.sf = it.c; it.sb = 3 - it.c; }
    return it;
}
__device__ void st_gla_passA(const Params& p, int bid, int nb, unsigned char* smem) {
    PG8_LAS unsigned char* lds3 = (PG8_LAS unsigned char*)smem;
    const int tid = threadIdx.x, lane = tid & 63, wv = __builtin_amdgcn_readfirstlane(tid >> 6);
    bf16_t* ST = (bf16_t*)(p.ws + WS_ST);
    float* DEC = (float*)(p.ws + WS_DEC);
    GlaRaw R; uint4 bw = make_uint4(0u, 0u, 0u, 0u); float bg = 0.f;
    __syncthreads();
    if (bid < 2080) { const GlaItem it0 = gla_item(bid); gla_fetch<false>(p, R, it0.row0, it0.h); gla_commit<false>(smem, R, bw, bg); }
    for (int item = bid; item < 2080; item += nb) {
        const GlaItem it = gla_item(item);
        const int chf = it.b * 8 + it.h * 2, chb = chf + 1;
        const bool has_next = item + nb < 2080;
        __syncthreads();
        if (has_next) { const GlaItem itn = gla_item(item + nb); gla_fetch<false>(p, R, itn.row0, itn.h); }
        __builtin_amdgcn_sched_barrier(0);
        gla_z(smem, bw, bg);
        __syncthreads();
        gla_prep<true>(smem, DEC + ((size_t)chf * GL_NS + it.sf) * 128, DEC + ((size_t)chb * GL_NS + it.sb) * 128);
        __syncthreads();
        const int e0 = wv * 32, r = lane & 31, hh = lane >> 5;
        bf16x8_t va[4];
#pragma unroll
        for (int ks = 0; ks < 4; ++ks) va[ks] = gla_vt_frag(lds3, e0, ks, lane);
#pragma unroll
        for (int dir = 0; dir < 2; ++dir) {
            f32x16_t acc[4];
#pragma unroll
            for (int nt = 0; nt < 4; ++nt)
#pragma unroll
                for (int i = 0; i < 16; ++i) acc[nt][i] = 0.f;
#pragma unroll
            for (int ks = 0; ks < 4; ++ks)
#pragma unroll
                for (int nt = 0; nt < 4; ++nt) {
                    const bf16x8_t bfr = *LDSP(bf16x8_t, GL_X + dir * (128 * GL_KS * 2) + ((nt * 32 + r) * GL_KS + ks * 16 + 8 * hh) * 2);
                    acc[nt] = __builtin_amdgcn_mfma_f32_32x32x16_bf16(va[ks], bfr, acc[nt], 0, 0, 0);
                }
            unsigned char* dst = (unsigned char*)ST + ((size_t)(dir ? chb : chf) * GL_NS + (dir ? it.sb : it.sf)) * 32768;
#pragma unroll
            for (int reg = 0; reg < 16; ++reg) {
                const int e = e0 + (reg & 3) + 8 * (reg >> 2) + 4 * hh;
                int o8 = __builtin_amdgcn_cvt_pk_fp8_f32(__builtin_amdgcn_fmed3f(acc[0][reg] * S8_SCALE, -448.f, 448.f), __builtin_amdgcn_fmed3f(acc[1][reg] * S8_SCALE, -448.f, 448.f), 0, false);
                o8 = __builtin_amdgcn_cvt_pk_fp8_f32(__builtin_amdgcn_fmed3f(acc[2][reg] * S8_SCALE, -448.f, 448.f), __builtin_amdgcn_fmed3f(acc[3][reg] * S8_SCALE, -448.f, 448.f), o8, true);
                *(int*)(dst + e * 128 + 4 * r) = o8;
            }
        }
        __syncthreads();
        if (has_next) gla_commit<false>(smem, R, bw, bg);
    }
}
constexpr int PB_N = 13, PB_NB = 20;
#define PB_LOAD(L, D, S0) { _Pragma("unroll") for (int u = 0; u < PB_N; ++u) { L[u] = *(const int*)(base + (size_t)((S0) + u) * 32768); D[u] = *(const float4*)(dbase + (size_t)((S0) + u) * 128); } }
#define PB_PROC(L, D, S0) { _Pragma("unroll") for (int u = 0; u < PB_N; ++u) { { int o8 = __builtin_amdgcn_cvt_pk_fp8_f32(__builtin_amdgcn_fmed3f(s0 * S8_SCALE, -448.f, 448.f), __builtin_amdgcn_fmed3f(s1 * S8_SCALE, -448.f, 448.f), 0, false); o8 = __builtin_amdgcn_cvt_pk_fp8_f32(__builtin_amdgcn_fmed3f(s2 * S8_SCALE, -448.f, 448.f), __builtin_amdgcn_fmed3f(s3 * S8_SCALE, -448.f, 448.f), o8, true); if (!DRY) *(int*)(base8 + (size_t)((S0) + u) * 32768) = o8; } \
        const f32x2_t l01 = __builtin_amdgcn_cvt_pk_f32_fp8(L[u], false), l23 = __builtin_amdgcn_cvt_pk_f32_fp8(L[u], true); \
        s0 = D[u].x * s0 + l01[0] * (1.0f / S8_SCALE); s1 = D[u].y * s1 + l01[1] * (1.0f / S8_SCALE); s2 = D[u].z * s2 + l23[0] * (1.0f / S8_SCALE); s3 = D[u].w * s3 + l23[1] * (1.0f / S8_SCALE); } }
template <bool DRY> __device__ void st_gla_passB(const Params& p, int bid, int nb) {
    bf16_t* ST = (bf16_t*)(p.ws + WS_ST);
    const float* DEC = (const float*)(p.ws + WS_DEC);
    for (int g = bid * NTHR + threadIdx.x; g < 16 * 8192; g += nb * NTHR) {
        const int chain = g >> 13, grp = g & 8191;
        const unsigned char* base = (const unsigned char*)ST + (size_t)chain * GL_NS * 32768 + grp * 4;
        const float* dbase = DEC + (size_t)chain * GL_NS * 128 + ((grp * 4) & 127);
        unsigned char* base8 = p.ws + WS_S8 + (size_t)chain * GL_NS * 32768 + grp * 4;
        float s0 = 0.f, s1 = 0.f, s2 = 0.f, s3 = 0.f;
        int La[PB_N], Lb[PB_N]; float4 Da[PB_N], Db[PB_N];
        PB_LOAD(La, Da, 0)
#pragma unroll 1
        for (int it = 0; it < PB_NB; it += 2) {
            PB_LOAD(Lb, Db, (it + 1) * PB_N)
            PB_PROC(La, Da, it * PB_N)
            if (it + 2 < PB_NB) PB_LOAD(La, Da, (it + 2) * PB_N)
            PB_PROC(Lb, Db, (it + 1) * PB_N)
        }
    }
}
__device__ void st_gla_passC(const Params& p, int bid, int nb, unsigned char* smem) {
    PG8_LAS unsigned char* lds3 = (PG8_LAS unsigned char*)smem;
    const int tid = threadIdx.x, lane = tid & 63, wv = __builtin_amdgcn_readfirstlane(tid >> 6);
    const bf16_t* ST = (const bf16_t*)(p.ws + WS_ST);
    const bf16_t* P = (const bf16_t*)(p.ws + WS_P);
    bf16_t* A = (bf16_t*)(p.ws + WS_A);
    GlaRaw R; uint4 bw = make_uint4(0u, 0u, 0u, 0u); float bg = 0.f;
#define GC_STATES(DF, DB, ITEM) { const GlaItem is_ = gla_item(ITEM); const int cf_ = is_.b * 8 + is_.h * 2; \
        const unsigned char* sf_ = p.ws + WS_S8 + ((size_t)cf_ * GL_NS + is_.sf) * 32768 + (size_t)(wv * 32 + (lane & 31)) * 128 + 8 * (lane >> 5); \
        const unsigned char* sb_ = p.ws + WS_S8 + ((size_t)(cf_ + 1) * GL_NS + is_.sb) * 32768 + (size_t)(wv * 32 + (lane & 31)) * 128 + 8 * (lane >> 5); \
        _Pragma("unroll") for (int ks = 0; ks < 8; ++ks) { DF[ks] = *(const uint2*)(sf_ + ks * 16); DB[ks] = *(const uint2*)(sb_ + ks * 16); } }
#define ST8_TO_BF16(RAW, DST) { const f32x2_t a_ = __builtin_amdgcn_cvt_pk_f32_fp8((int)RAW.x, false), b_ = __builtin_amdgcn_cvt_pk_f32_fp8((int)RAW.x, true), c_ = __builtin_amdgcn_cvt_pk_f32_fp8((int)RAW.y, false), d_ = __builtin_amdgcn_cvt_pk_f32_fp8((int)RAW.y, true); \
        uint4 w_; w_.x = pack2(a_[0] * (1.0f / S8_SCALE), a_[1] * (1.0f / S8_SCALE)); w_.y = pack2(b_[0] * (1.0f / S8_SCALE), b_[1] * (1.0f / S8_SCALE)); w_.z = pack2(c_[0] * (1.0f / S8_SCALE), c_[1] * (1.0f / S8_SCALE)); w_.w = pack2(d_[0] * (1.0f / S8_SCALE), d_[1] * (1.0f / S8_SCALE)); DST = __builtin_bit_cast(bf16x8_t, w_); }
    uint2 csf[8], csb[8];
#pragma unroll
    for (int ks = 0; ks < 8; ++ks) { csf[ks] = make_uint2(0u, 0u); csb[ks] = make_uint2(0u, 0u); }
    __syncthreads();
    if (bid < 2048) { const GlaItem it0 = gla_item(bid); gla_fetch<true>(p, R, it0.row0, it0.h); gla_commit<true>(smem, R, bw, bg); GC_STATES(csf, csb, bid) }
    for (int item = bid; item < 2048; item += nb) {
        const GlaItem it = gla_item(item);
        const int chf = it.b * 8 + it.h * 2, chb = chf + 1;
        const bool has_next = item + nb < 2048;
        __syncthreads();
        const int e0 = wv * 32, r = lane & 31, hh = lane >> 5;
        uint2 nsf[8], nsb[8];
#pragma unroll
        for (int ks = 0; ks < 8; ++ks) { nsf[ks] = make_uint2(0u, 0u); nsb[ks] = make_uint2(0u, 0u); }
        if (has_next) { const GlaItem itn = gla_item(item + nb); gla_fetch<true>(p, R, itn.row0, itn.h); GC_STATES(nsf, nsb, item + nb) }
        __builtin_amdgcn_sched_barrier(0);
        gla_z(smem, bw, bg);
        __syncthreads();
        gla_prep<false>(smem, nullptr, nullptr);
        __syncthreads();
        {
            const int l15 = lane & 15, l4 = lane >> 4;
            unsigned bt = GL_X + (l15 * GL_XS + l4 * 8) * 2; asm volatile("" : "+v"(bt));
#pragma unroll
            for (int tt = 0; tt < 2; ++tt) {
                const int T = wv * 2 + tt, jt = T >> 2, itl = T & 3;
                const unsigned ba = bt + jt * (16 * GL_XS * 2), bq = bt + itl * (16 * GL_XS * 2);
                f32x4_t af = {0.f, 0.f, 0.f, 0.f}, ab = {0.f, 0.f, 0.f, 0.f};
                if (jt <= itl) {
#pragma unroll
                    for (int ks = 0; ks < 4; ++ks) {
                        const bf16x8_t a = *LDSP(bf16x8_t, ba + 1 * 64 * GL_XS * 2 + ks * 64);
                        const bf16x8_t bb = *LDSP(bf16x8_t, bq + 0 * 64 * GL_XS * 2 + ks * 64);
                        af = __builtin_amdgcn_mfma_f32_16x16x32_bf16(a, bb, af, 0, 0, 0);
                    }
                }
                if (jt >= itl) {
#pragma unroll
                    for (int ks = 0; ks < 4; ++ks) {
                        const bf16x8_t a = *LDSP(bf16x8_t, ba + 3 * 64 * GL_XS * 2 + ks * 64);
                        const bf16x8_t bb = *LDSP(bf16x8_t, bq + 2 * 64 * GL_XS * 2 + ks * 64);
                        ab = __builtin_amdgcn_mfma_f32_16x16x32_bf16(a, bb, ab, 0, 0, 0);
                    }
                }
                const int i = itl * 16 + l15;
                float pv[4];
#pragma unroll
                for (int reg = 0; reg < 4; ++reg) { const int j = jt * 16 + l4 * 4 + reg; pv[reg] = (j <= i ? af[reg] : 0.f) + (j >= i ? ab[reg] : 0.f); }
                uint2 wq; wq.x = pack2(pv[0], pv[1]); wq.y = pack2(pv[2], pv[3]);
                *(uint2*)(smem + GL_P + (i * GL_KS + jt * 16 + l4 * 4) * 2) = wq;
            }
        }
        __syncthreads();
        f32x16_t acc0, acc1;
#pragma unroll
        for (int i = 0; i < 16; ++i) { acc0[i] = 0.f; acc1[i] = 0.f; }
        {
            unsigned bp = GL_P + (r * GL_KS + 8 * hh) * 2; asm volatile("" : "+v"(bp));
#pragma unroll
            for (int ks = 0; ks < 4; ++ks) {
                const bf16x8_t a = gla_vt_frag(lds3, e0, ks, lane);
                const bf16x8_t b0 = *LDSP(bf16x8_t, bp + ks * 32);
                const bf16x8_t b1 = *LDSP(bf16x8_t, bp + 32 * GL_KS * 2 + ks * 32);
                acc0 = __builtin_amdgcn_mfma_f32_32x32x16_bf16(a, b0, acc0, 0, 0, 0);
                acc1 = __builtin_amdgcn_mfma_f32_32x32x16_bf16(a, b1, acc1, 0, 0, 0);
            }
            unsigned bx = GL_X + (r * GL_XS + 8 * hh) * 2; asm volatile("" : "+v"(bx));
#pragma unroll
            for (int ks = 0; ks < 8; ++ks) {
                const bf16x8_t b0 = *LDSP(bf16x8_t, bx + 0 * 64 * GL_XS * 2 + ks * 32);
                const bf16x8_t b1 = *LDSP(bf16x8_t, bx + 0 * 64 * GL_XS * 2 + 32 * GL_XS * 2 + ks * 32);
                bf16x8_t sa_; ST8_TO_BF16(csf[ks], sa_)
                acc0 = __builtin_amdgcn_mfma_f32_32x32x16_bf16(sa_, b0, acc0, 0, 0, 0);
                acc1 = __builtin_amdgcn_mfma_f32_32x32x16_bf16(sa_, b1, acc1, 0, 0, 0);
            }
#pragma unroll
            for (int ks = 0; ks < 8; ++ks) {
                const bf16x8_t b0 = *LDSP(bf16x8_t, bx + 2 * 64 * GL_XS * 2 + ks * 32);
                const bf16x8_t b1 = *LDSP(bf16x8_t, bx + 2 * 64 * GL_XS * 2 + 32 * GL_XS * 2 + ks * 32);
                bf16x8_t sa_; ST8_TO_BF16(csb[ks], sa_)
                acc0 = __builtin_amdgcn_mfma_f32_32x32x16_bf16(sa_, b0, acc0, 0, 0, 0);
                acc1 = __builtin_amdgcn_mfma_f32_32x32x16_bf16(sa_, b1, acc1, 0, 0, 0);
            }
        }
        __syncthreads();
        uint4 gbv[4]; float4 n0v[4], n1v[4];
        {
            const size_t rowg = it.row0 + (tid >> 3);
            const int cg0 = it.h * 256 + (tid & 7) * 32;
#pragma unroll
            for (int q = 0; q < 4; ++q) { gbv[q] = *(const uint4*)(P + rowg * NP + PC_G + cg0 + q * 8); n0v[q] = *(const float4*)(p.in[I_GNG] + cg0 + q * 8); n1v[q] = *(const float4*)(p.in[I_GNG] + cg0 + q * 8 + 4); }
        }
        __builtin_amdgcn_sched_barrier(0);
        if (has_next) gla_commit<true>(smem, R, bw, bg);
        {
            float* ob = (float*)(smem + GL_OBUF);
#pragma unroll
            for (int g4 = 0; g4 < 4; ++g4) {
                const int e = e0 + 8 * g4 + 4 * hh;
                float4 o0; o0.x = acc0[g4 * 4 + 0]; o0.y = acc0[g4 * 4 + 1]; o0.z = acc0[g4 * 4 + 2]; o0.w = acc0[g4 * 4 + 3];
                float4 o1; o1.x = acc1[g4 * 4 + 0]; o1.y = acc1[g4 * 4 + 1]; o1.z = acc1[g4 * 4 + 2]; o1.w = acc1[g4 * 4 + 3];
                *(float4*)(ob + (r) * 260 + e) = o0;
                *(float4*)(ob + (32 + r) * 260 + e) = o1;
            }
        }
        __syncthreads();
        {
            const float* ob = (const float*)(smem + GL_OBUF);
            int tid2 = tid; asm volatile("" : "+v"(tid2));
            const int i = tid2 >> 3, part = tid2 & 7;
            float o[32];
            float ss = 0.f;
#pragma unroll
            for (int q = 0; q < 8; ++q) { const float4 v = *(const float4*)(ob + i * 260 + part * 32 + q * 4); o[q * 4 + 0] = v.x; o[q * 4 + 1] = v.y; o[q * 4 + 2] = v.z; o[q * 4 + 3] = v.w; ss += v.x * v.x + v.y * v.y + v.z * v.z + v.w * v.w; }
            ss += __shfl_xor(ss, 1); ss += __shfl_xor(ss, 2); ss += __shfl_xor(ss, 4);
            const float rs = rsqrtf(ss * (1.0f / 256.0f) + EPS);
            const size_t row = it.row0 + i;
            const int c0 = it.h * 256 + part * 32;
#pragma unroll
            for (int q = 0; q < 4; ++q) {
                const uint4 gb = gbv[q];
                const float4 n0 = n0v[q], n1 = n1v[q];
                uint4 wq;
                wq.x = pack2(o[q * 8 + 0] * rs * n0.x * silu_f(bflo(gb.x)), o[q * 8 + 1] * rs * n0.y * silu_f(bfhi(gb.x)));
                wq.y = pack2(o[q * 8 + 2] * rs * n0.z * silu_f(bflo(gb.y)), o[q * 8 + 3] * rs * n0.w * silu_f(bfhi(gb.y)));
                wq.z = pack2(o[q * 8 + 4] * rs * n1.x * silu_f(bflo(gb.z)), o[q * 8 + 5] * rs * n1.y * silu_f(bfhi(gb.z)));
                wq.w = pack2(o[q * 8 + 6] * rs * n1.z * silu_f(bflo(gb.w)), o[q * 8 + 7] * rs * n1.w * silu_f(bfhi(gb.w)));
                *(uint4*)(A + row * DM + c0 + q * 8) = wq;
            }
        }
#pragma unroll
        for (int ks = 0; ks < 8; ++ks) { csf[ks] = nsf[ks]; csb[ks] = nsb[ks]; }
    }
#undef GC_STATES
#undef ST8_TO_BF16
}

__device__ void st_cmlp_naive(const Params& p, int bid, int nb, float* lds) {
    const int tid = threadIdx.x, lane = tid & 63, wv = tid >> 6;
    const bf16_t* P = (const bf16_t*)(p.ws + WS_P);
    bf16_t* A = (bf16_t*)(p.ws + WS_A);
    float* sWT = lds; float* sV = lds + 16384; float* smu = lds + 32768; float* srs = lds + 32768 + 128;
    for (int chunk = bid; chunk < 256; chunk += nb) {
        const int r0 = chunk * 128;
        __syncthreads();
        for (int tt = 0; tt < 16; ++tt) {
            const int q = wv * 16 + tt;
            const bf16_t* pr = P + (size_t)(r0 + q) * NP + PC_V2;
            const uint4 a = *(const uint4*)(pr + lane * 8), b2 = *(const uint4*)(pr + 512 + lane * 8);
            float v[16];
            v[0] = bflo(a.x); v[1] = bfhi(a.x); v[2] = bflo(a.y); v[3] = bfhi(a.y); v[4] = bflo(a.z); v[5] = bfhi(a.z); v[6] = bflo(a.w); v[7] = bfhi(a.w);
            v[8] = bflo(b2.x); v[9] = bfhi(b2.x); v[10] = bflo(b2.y); v[11] = bfhi(b2.y); v[12] = bflo(b2.z); v[13] = bfhi(b2.z); v[14] = bflo(b2.w); v[15] = bfhi(b2.w);
            float s = 0.f;
#pragma unroll
            for (int j = 0; j < 16; ++j) s += v[j];
            s = wave_sum(s);
            const float mu = s * (1.0f / 1024.0f);
            float ss = 0.f;
#pragma unroll
            for (int j = 0; j < 16; ++j) { const float d = v[j] - mu; ss += d * d; }
            ss = wave_sum(ss);
            if (lane == 0) { smu[q] = mu; srs[q] = rsqrtf(ss * (1.0f / 1024.0f) + EPS); }
        }
        __syncthreads();
        for (int g = 0; g < 8; ++g) {
            {
                const float* Wg = p.in[I_WS] + (size_t)g * 16384;
                const int pl = tid & 127, qq = tid >> 7;
#pragma unroll
                for (int it = 0; it < 8; ++it) {
                    const int q4 = qq + 4 * it;
                    const float4 w = *(const float4*)(Wg + pl * 128 + q4 * 4);
                    sWT[(q4 * 4 + 0) * 128 + pl] = w.x; sWT[(q4 * 4 + 1) * 128 + pl] = w.y; sWT[(q4 * 4 + 2) * 128 + pl] = w.z; sWT[(q4 * 4 + 3) * 128 + pl] = w.w;
                }
            }
            {
                const int q = tid >> 2, cs = tid & 3;
                const float mu = smu[q], rs = srs[q];
                const bf16_t* pr = P + (size_t)(r0 + q) * NP + PC_V2 + g * 128 + cs * 32;
#pragma unroll
                for (int i = 0; i < 4; ++i) {
                    const uint4 a = *(const uint4*)(pr + i * 8);
                    const int c = g * 128 + cs * 32 + i * 8;
                    const float4 lg0 = *(const float4*)(p.in[I_LNG] + c), lg1 = *(const float4*)(p.in[I_LNG] + c + 4);
                    const float4 lb0 = *(const float4*)(p.in[I_LNB] + c), lb1 = *(const float4*)(p.in[I_LNB] + c + 4);
                    float* d = sV + q * 128 + cs * 32 + i * 8;
                    d[0] = (bflo(a.x) - mu) * rs * lg0.x + lb0.x; d[1] = (bfhi(a.x) - mu) * rs * lg0.y + lb0.y;
                    d[2] = (bflo(a.y) - mu) * rs * lg0.z + lb0.z; d[3] = (bfhi(a.y) - mu) * rs * lg0.w + lb0.w;
                    d[4] = (bflo(a.z) - mu) * rs * lg1.x + lb1.x; d[5] = (bfhi(a.z) - mu) * rs * lg1.y + lb1.y;
                    d[6] = (bflo(a.w) - mu) * rs * lg1.z + lb1.z; d[7] = (bfhi(a.w) - mu) * rs * lg1.w + lb1.w;
                }
            }
            __syncthreads();
            const int pg = tid >> 4, cgi = tid & 15;
            float acc[4][8];
#pragma unroll
            for (int i = 0; i < 4; ++i)
#pragma unroll
                for (int j = 0; j < 8; ++j) acc[i][j] = 0.f;
#pragma unroll 4
            for (int q = 0; q < 128; ++q) {
                const float4 w = *(const float4*)(sWT + q * 128 + pg * 4);
                const float4 v0 = *(const float4*)(sV + q * 128 + cgi * 8), v1 = *(const float4*)(sV + q * 128 + cgi * 8 + 4);
                const float wv4[4] = {w.x, w.y, w.z, w.w};
                const float vv[8] = {v0.x, v0.y, v0.z, v0.w, v1.x, v1.y, v1.z, v1.w};
#pragma unroll
                for (int i = 0; i < 4; ++i)
#pragma unroll
                    for (int j = 0; j < 8; ++j) acc[i][j] += wv4[i] * vv[j];
            }
#pragma unroll
            for (int i = 0; i < 4; ++i) {
                const int pp = pg * 4 + i; const size_t row = (size_t)(r0 + pp);
                const float bs = p.in[I_BS][g * 128 + pp];
                const uint4 u8 = *(const uint4*)(P + row * NP + PC_U + g * 128 + cgi * 8);
                uint4 w;
                w.x = pack2(bflo(u8.x) * (acc[i][0] + bs), bfhi(u8.x) * (acc[i][1] + bs));
                w.y = pack2(bflo(u8.y) * (acc[i][2] + bs), bfhi(u8.y) * (acc[i][3] + bs));
                w.z = pack2(bflo(u8.z) * (acc[i][4] + bs), bfhi(u8.z) * (acc[i][5] + bs));
                w.w = pack2(bflo(u8.w) * (acc[i][6] + bs), bfhi(u8.w) * (acc[i][7] + bs));
                *(uint4*)(A + row * DM + 1024 + g * 128 + cgi * 8) = w;
            }
            __syncthreads();
        }
    }
}

__device__ __forceinline__ unsigned fkey(float f) { const unsigned u = __float_as_uint(f); return (u & 0x80000000u) ? ~u : (u | 0x80000000u); }
template <int NV>
__device__ __forceinline__ void select16(const float (&val)[NV], const int (&id)[NV], float* ov, int* oi, int lane) {
    unsigned key[NV];
#pragma unroll
    for (int v = 0; v < NV; ++v) key[v] = fkey(val[v]);
    unsigned prefix = 0u;
    for (int bit = 31; bit >= 0; --bit) {
        const unsigned cand = prefix | (1u << bit);
        int cnt = 0;
#pragma unroll
        for (int v = 0; v < NV; ++v) cnt += __popcll(__ballot(key[v] >= cand));
        if (cnt >= 16) prefix = cand;
    }
    unsigned long long mgt[NV], meq[NV]; int ngt = 0;
#pragma unroll
    for (int v = 0; v < NV; ++v) { mgt[v] = __ballot(key[v] > prefix); meq[v] = __ballot(key[v] == prefix); ngt += __popcll(mgt[v]); }
    const int need = 16 - ngt;
    const unsigned long long lt = (1ull << lane) - 1ull;
    int base = 0, ebase = 0;
#pragma unroll
    for (int v = 0; v < NV; ++v) {
        if (key[v] > prefix) { const int pos = base + __popcll(mgt[v] & lt); ov[pos] = val[v]; oi[pos] = id[v]; }
        else if (key[v] == prefix) { const int er = ebase + __popcll(meq[v] & lt); if (er < need) { ov[ngt + er] = val[v]; oi[ngt + er] = id[v]; } }
        base += __popcll(mgt[v]); ebase += __popcll(meq[v]);
    }
}
__device__ void st_topk_naive(const Params& p, int bid, int nb, float* lds) {
    const int tid = threadIdx.x, lane = tid & 63, wv = __builtin_amdgcn_readfirstlane(tid >> 6);
    const float* Q = (const float*)(p.ws + WS_Q);
    int* IDX = (int*)(p.ws + WS_IDX); float* GATE = (float*)(p.ws + WS_GATE);
    float* sK = lds;
    float* wq = lds + 33792 + wv * 384;
    float* v1 = wq + 256; int* i1 = (int*)(wq + 272); float* v2 = wq + 288; int* i2 = (int*)(wq + 304); float* bv = wq + 320; int* be = (int*)(wq + 336);
    for (int item = bid; item < 256; item += nb) {
        const int h = item & 7, tr = item >> 3;
        __syncthreads();
        for (int i = tid; i < 2 * 128 * 32; i += NTHR) {
            const int hf = i >> 12, k = (i >> 5) & 127, d4 = i & 31;
            const float4 w = *(const float4*)(p.in[I_SK] + ((size_t)(hf * 8 + h) * 128 + k) * 128 + d4 * 4);
            *(float4*)(sK + (hf * 128 + k) * 132 + d4 * 4) = w;
        }
        __syncthreads();
        for (int tt = wv; tt < 1024; tt += 8) {
            const int t = tr * 1024 + tt;
            wave_lds_fence();
            *(float4*)(wq + lane * 4) = *(const float4*)(Q + (size_t)t * DM + h * 256 + lane * 4);
            wave_lds_fence();
            float s[2][2] = {{0.f, 0.f}, {0.f, 0.f}};
#pragma unroll
            for (int hf = 0; hf < 2; ++hf)
#pragma unroll 8
                for (int d4 = 0; d4 < 32; ++d4) {
                    const float4 qq = *(const float4*)(wq + hf * 128 + d4 * 4);
#pragma unroll
                    for (int kk = 0; kk < 2; ++kk) {
                        const float4 kv = *(const float4*)(sK + (hf * 128 + lane + 64 * kk) * 132 + d4 * 4);
                        s[hf][kk] += qq.x * kv.x + qq.y * kv.y + qq.z * kv.z + qq.w * kv.w;
                    }
                }
            const int ids[2] = {lane, lane + 64};
            select16<2>(s[0], ids, v1, i1, lane);
            select16<2>(s[1], ids, v2, i2, lane);
            wave_lds_fence();
            float cand[4]; int cid[4];
            {
                const int a = lane >> 2, b0 = (lane & 3) * 4;
                const float va = v1[a]; const int ia = i1[a];
#pragma unroll
                for (int j = 0; j < 4; ++j) { cand[j] = va + v2[b0 + j]; cid[j] = ia * 128 + i2[b0 + j]; }
            }
            select16<4>(cand, cid, bv, be, lane);
            wave_lds_fence();
            const float x = lane < 16 ? bv[lane] : -3.0e38f;
            const float mx = wave_max(x);
            const float ex = lane < 16 ? expf(x - mx) : 0.f;
            const float sm = wave_sum(ex);
            if (lane < 16) { IDX[(size_t)t * 128 + h * 16 + lane] = be[lane]; GATE[(size_t)t * 128 + h * 16 + lane] = ex / sm; }
        }
    }
}

constexpr int CM_VS = 160;
constexpr int CM_TILE = 128 * CM_VS * 2;
constexpr int CM_MU = 2 * CM_TILE, CM_RS = CM_MU + 512, CM_BS = CM_RS + 512;
__device__ void st_cmlp_mfma(const Params& p, int bid, int nb, unsigned char* smem) {
    PG8_LAS unsigned char* lds3 = (PG8_LAS unsigned char*)smem;
    const int tid = threadIdx.x, lane = tid & 63, wv = __builtin_amdgcn_readfirstlane(tid >> 6);
    const bf16_t* P = (const bf16_t*)(p.ws + WS_P);
    bf16_t* A = (bf16_t*)(p.ws + WS_A);
    float* smu = (float*)(smem + CM_MU); float* srs = (float*)(smem + CM_RS);
    for (int i = tid; i < 1024; i += NTHR) *(PG8_LAS float*)(lds3 + CM_BS + i * 4) = p.in[I_BS][i];
    for (int chunk = bid; chunk < 256; chunk += nb) {
        const int r0 = chunk * 128;
        __syncthreads();
        for (int tt = 0; tt < 16; ++tt) {
            const int q = wv * 16 + tt;
            const bf16_t* pr = P + (size_t)(r0 + q) * NP + PC_V2;
            const uint4 a = *(const uint4*)(pr + lane * 8), b2 = *(const uint4*)(pr + 512 + lane * 8);
            float v[16];
            v[0] = bflo(a.x); v[1] = bfhi(a.x); v[2] = bflo(a.y); v[3] = bfhi(a.y); v[4] = bflo(a.z); v[5] = bfhi(a.z); v[6] = bflo(a.w); v[7] = bfhi(a.w);
            v[8] = bflo(b2.x); v[9] = bfhi(b2.x); v[10] = bflo(b2.y); v[11] = bfhi(b2.y); v[12] = bflo(b2.z); v[13] = bfhi(b2.z); v[14] = bflo(b2.w); v[15] = bfhi(b2.w);
            float sm = 0.f;
#pragma unroll
            for (int j = 0; j < 16; ++j) sm += v[j];
            sm = wave_sum(sm);
            const float mu = sm * (1.0f / 1024.0f);
            float ss = 0.f;
#pragma unroll
            for (int j = 0; j < 16; ++j) { const float d = v[j] - mu; ss += d * d; }
            ss = wave_sum(ss);
            if (lane == 0) { smu[q] = mu; srs[q] = rsqrtf(ss * (1.0f / 1024.0f) + EPS); }
        }
        __syncthreads();
        for (int gp = 0; gp < 4; ++gp) {
            {
                const int gsel = tid >> 8, q = (tid >> 1) & 127, half = tid & 1;
                const int g = gp * 2 + gsel;
                const float mu = smu[q], rs = srs[q];
                const bf16_t* pr = P + (size_t)(r0 + q) * NP + PC_V2 + g * 128 + half * 64;
                PG8_LAS unsigned char* img = lds3 + gsel * CM_TILE + q * (CM_VS * 2);
                uint4 av[8];
#pragma unroll
                for (int i = 0; i < 8; ++i) av[i] = *(const uint4*)(pr + i * 8);
#pragma unroll
                for (int i = 0; i < 8; ++i) {
                    const uint4 a = av[i];
                    const int c = g * 128 + half * 64 + i * 8;
                    const float4 lg0 = *(const float4*)(p.in[I_LNG] + c), lg1 = *(const float4*)(p.in[I_LNG] + c + 4);
                    const float4 lb0 = *(const float4*)(p.in[I_LNB] + c), lb1 = *(const float4*)(p.in[I_LNB] + c + 4);
                    const float n0 = (bflo(a.x) - mu) * rs * lg0.x + lb0.x, n1 = (bfhi(a.x) - mu) * rs * lg0.y + lb0.y;
                    const float n2 = (bflo(a.y) - mu) * rs * lg0.z + lb0.z, n3 = (bfhi(a.y) - mu) * rs * lg0.w + lb0.w;
                    const float n4 = (bflo(a.z) - mu) * rs * lg1.x + lb1.x, n5 = (bfhi(a.z) - mu) * rs * lg1.y + lb1.y;
                    const float n6 = (bflo(a.w) - mu) * rs * lg1.z + lb1.z, n7 = (bfhi(a.w) - mu) * rs * lg1.w + lb1.w;
                    const int cq = (half * 64 + i * 8) >> 2;
                    *(PG8_LAS unsigned*)(img + (0 * 32 + cq) * 2) = pack2(n0, n4);
                    *(PG8_LAS unsigned*)(img + (1 * 32 + cq) * 2) = pack2(n1, n5);
                    *(PG8_LAS unsigned*)(img + (2 * 32 + cq) * 2) = pack2(n2, n6);
                    *(PG8_LAS unsigned*)(img + (3 * 32 + cq) * 2) = pack2(n3, n7);
                }
            }
            __syncthreads();
            {
                const int g = gp * 2 + (wv >> 2), mt = wv & 3;
                const int r = lane & 31, hh = lane >> 5;
                const float* wrow = p.in[I_WS] + ((size_t)g * 128 + mt * 32 + r) * 128 + 8 * hh;
                f32x16_t acc[4];
#pragma unroll
                for (int nt = 0; nt < 4; ++nt)
#pragma unroll
                    for (int i = 0; i < 16; ++i) acc[nt][i] = 0.f;
                uint2 upre[16];
#pragma unroll
                for (int reg = 0; reg < 16; ++reg) {
                    const int pp2 = mt * 32 + (reg & 3) + 8 * (reg >> 2) + 4 * hh;
                    upre[reg] = *(const uint2*)(P + (size_t)(r0 + pp2) * NP + PC_U + g * 128 + 4 * r);
                }
                __builtin_amdgcn_sched_barrier(0);
                const int grp = lane >> 4, li = lane & 15, qq = li >> 2, pp = li & 3;
                unsigned bv = (wv >> 2) * CM_TILE + ((8 * (grp >> 1) + qq) * CM_VS + 16 * (grp & 1) + 4 * pp) * 2; asm volatile("" : "+v"(bv));
#pragma unroll
                for (int ks = 0; ks < 8; ++ks) {
                    const float4 wa = *(const float4*)(wrow + ks * 16), wb = *(const float4*)(wrow + ks * 16 + 4);
                    uint4 aw; aw.x = pack2(wa.x, wa.y); aw.y = pack2(wa.z, wa.w); aw.z = pack2(wb.x, wb.y); aw.w = pack2(wb.z, wb.w);
                    const bf16x8_t af = __builtin_bit_cast(bf16x8_t, aw);
#pragma unroll
                    for (int nt = 0; nt < 4; ++nt) {
                        const s16x4_t lo = __builtin_amdgcn_ds_read_tr16_b64_v4i16(LDSP(s16x4_t, bv + ks * (16 * CM_VS * 2) + nt * 64));
                        const s16x4_t hi = __builtin_amdgcn_ds_read_tr16_b64_v4i16(LDSP(s16x4_t, bv + ks * (16 * CM_VS * 2) + 4 * CM_VS * 2 + nt * 64));
                        const bf16x8_t bfr = __builtin_shufflevector(lo, hi, 0, 1, 2, 3, 4, 5, 6, 7);
                        acc[nt] = __builtin_amdgcn_mfma_f32_32x32x16_bf16(af, bfr, acc[nt], 0, 0, 0);
                    }
                }
#pragma unroll
                for (int reg = 0; reg < 16; ++reg) {
                    const int pp2 = mt * 32 + (reg & 3) + 8 * (reg >> 2) + 4 * hh; const size_t row = (size_t)(r0 + pp2);
                    const float bs = *(const PG8_LAS float*)(lds3 + CM_BS + (g * 128 + pp2) * 4);
                    const uint2 u4 = upre[reg];
                    uint2 w;
                    w.x = pack2(bflo(u4.x) * (acc[0][reg] + bs), bfhi(u4.x) * (acc[1][reg] + bs));
                    w.y = pack2(bflo(u4.y) * (acc[2][reg] + bs), bfhi(u4.y) * (acc[3][reg] + bs));
                    *(uint2*)(A + row * DM + 1024 + g * 128 + 4 * r) = w;
                }
            }
            __syncthreads();
        }
    }
}

constexpr int TK_KS = 136;
constexpr int TK_KEYS = 0;
constexpr int TK_TAB = 139264;
constexpr int TK_SCR = 139328;
__device__ __forceinline__ unsigned tk_ord(float f) { const unsigned u = __float_as_uint(f); return u ^ ((unsigned)((int)u >> 31) | 0x80000000u); }
__device__ __forceinline__ float tk_unord(unsigned k) { return __uint_as_float((k & 0x80000000u) ? (k ^ 0x80000000u) : ~k); }
#define TK_CE(a, b) { const unsigned mx_ = max(a, b), mn_ = min(a, b); a = mx_; b = mn_; }
template <int N> __device__ __forceinline__ void tk_sort16(unsigned (&k)[N], const int base) {
#pragma unroll
    for (int size = 2; size <= 16; size *= 2)
#pragma unroll
        for (int stride = size / 2; stride >= 1; stride /= 2)
#pragma unroll
            for (int i = 0; i < 16; ++i) {
                const int j = i ^ stride;
                if (j > i) { if ((i & size) == 0 || size == 16) { TK_CE(k[base + i], k[base + j]) } else { TK_CE(k[base + j], k[base + i]) } }
            }
}
template <int N> __device__ __forceinline__ void tk_merge16(unsigned (&k)[N], const int a0, const int b0) {
#pragma unroll
    for (int i = 0; i < 16; ++i) k[a0 + i] = max(k[a0 + i], k[b0 + 15 - i]);
#pragma unroll
    for (int stride = 8; stride >= 1; stride /= 2)
#pragma unroll
        for (int i = 0; i < 16; ++i) { const int j = i ^ stride; if (j > i) { TK_CE(k[a0 + i], k[a0 + j]) } }
}
__device__ void st_topk_mfma(const Params& p, int bid, int nb, unsigned char* smem) {
    PG8_LAS unsigned char* lds3 = (PG8_LAS unsigned char*)smem;
    const int tid = threadIdx.x, lane = tid & 63, wv = __builtin_amdgcn_readfirstlane(tid >> 6);
    const bf16_t* Q = (const bf16_t*)(p.ws + WS_Q);
    int* IDX = (int*)(p.ws + WS_IDX); float* GATE = (float*)(p.ws + WS_GATE);
    const int r = lane & 31, hh = lane >> 5;
    for (int item = bid; item < 256; item += nb) {
        const int h = item & 7, tr = item >> 3;
        __syncthreads();
        for (int i = tid; i < 4 * 128 * 16; i += NTHR) {
            const int sel = i >> 11, k = (i >> 4) & 127, seg = i & 15, hf = sel >> 1, hl = sel & 1;
            const u32x4_t w = *(const u32x4_t*)((const unsigned short*)(p.ws + WS_SKH) + ((size_t)((hf * 8 + h) * 2 + hl) * 128 + k) * 128 + seg * 8);
            *LDSP(u32x4_t, TK_KEYS + ((sel * 128 + k) * TK_KS + seg * 8) * 2) = w;
        }
        if (tid < 64) {
            int c = 0, val = 0;
            for (int a = 0; a < 16; ++a) for (int b = 0; b < 16 / (a + 1); ++b) { if (c == tid) val = a * 16 + b; ++c; }
            smem[TK_TAB + tid] = (unsigned char)val;
        }
        __syncthreads();
        for (int u = wv; u < 32; u += 8) {
            const int t0 = tr * 1024 + u * 32;
            const bf16_t* qrow = Q + (size_t)(t0 + r) * DM + h * 256 + 8 * hh;
            unsigned ka = TK_KEYS + (r * TK_KS + 8 * hh) * 2; asm volatile("" : "+v"(ka));
            f32x16_t acc[2][4];
            uint4 qraw[2][8];
#pragma unroll
            for (int hf = 0; hf < 2; ++hf)
#pragma unroll
                for (int ks = 0; ks < 8; ++ks) qraw[hf][ks] = *(const uint4*)(qrow + hf * 128 + ks * 16);
#pragma unroll
            for (int hf = 0; hf < 2; ++hf)
#pragma unroll
                for (int ks = 0; ks < 8; ks += 2)
                    asm volatile("" : "+v"(qraw[hf][ks].x), "+v"(qraw[hf][ks].y), "+v"(qraw[hf][ks].z), "+v"(qraw[hf][ks].w), "+v"(qraw[hf][ks + 1].x), "+v"(qraw[hf][ks + 1].y), "+v"(qraw[hf][ks + 1].z), "+v"(qraw[hf][ks + 1].w));
#pragma unroll
            for (int hf = 0; hf < 2; ++hf) {
#pragma unroll
                for (int mt = 0; mt < 4; ++mt)
#pragma unroll
                    for (int i = 0; i < 16; ++i) acc[hf][mt][i] = 0.f;
#pragma unroll
                for (int ks = 0; ks < 8; ++ks) {
                    const bf16x8_t bq = __builtin_bit_cast(bf16x8_t, qraw[hf][ks]);
#pragma unroll
                    for (int mt = 0; mt < 4; ++mt) {
                        const bf16x8_t ah = *LDSP(bf16x8_t, ka + ((hf * 2 + 0) * 128 + mt * 32) * TK_KS * 2 + ks * 32);
                        const bf16x8_t al = *LDSP(bf16x8_t, ka + ((hf * 2 + 1) * 128 + mt * 32) * TK_KS * 2 + ks * 32);
                        acc[hf][mt] = __builtin_amdgcn_mfma_f32_32x32x16_bf16(ah, bq, acc[hf][mt], 0, 0, 0);
                        acc[hf][mt] = __builtin_amdgcn_mfma_f32_32x32x16_bf16(al, bq, acc[hf][mt], 0, 0, 0);
                    }
                }
            }
            unsigned k[128];
#pragma unroll
            for (int mt = 0; mt < 4; ++mt)
#pragma unroll
                for (int reg = 0; reg < 16; ++reg) {
                    const auto sw = __builtin_amdgcn_permlane32_swap(__float_as_uint(acc[0][mt][reg]), __float_as_uint(acc[1][mt][reg]), false, false);
                    const int kidx = 32 * mt + (reg & 3) + 8 * (reg >> 2);
                    k[mt * 32 + reg] = (tk_ord(__uint_as_float(sw[0])) & 0xFFFFFF80u) | (unsigned)kidx;
                    k[mt * 32 + 16 + reg] = (tk_ord(__uint_as_float(sw[1])) & 0xFFFFFF80u) | (unsigned)(kidx + 4);
                }
#pragma unroll
            for (int g = 0; g < 8; ++g) tk_sort16(k, g * 16);
            tk_merge16(k, 0, 16); tk_merge16(k, 32, 48); tk_merge16(k, 64, 80); tk_merge16(k, 96, 112);
            tk_merge16(k, 0, 32); tk_merge16(k, 64, 96);
            tk_merge16(k, 0, 64);
            unsigned X[16], Y[16];
#pragma unroll
            for (int j = 0; j < 16; ++j) { const auto sw = __builtin_amdgcn_permlane32_swap(k[j], k[j], false, false); X[j] = sw[0]; Y[j] = sw[1]; }
            {
                uint4 w0, w1;
                w0.x = (X[0] & 127u) | ((X[1] & 127u) << 8) | ((X[2] & 127u) << 16) | ((X[3] & 127u) << 24);
                w0.y = (X[4] & 127u) | ((X[5] & 127u) << 8) | ((X[6] & 127u) << 16) | ((X[7] & 127u) << 24);
                w0.z = (X[8] & 127u) | ((X[9] & 127u) << 8) | ((X[10] & 127u) << 16) | ((X[11] & 127u) << 24);
                w0.w = (X[12] & 127u) | ((X[13] & 127u) << 8) | ((X[14] & 127u) << 16) | ((X[15] & 127u) << 24);
                w1.x = (Y[0] & 127u) | ((Y[1] & 127u) << 8) | ((Y[2] & 127u) << 16) | ((Y[3] & 127u) << 24);
                w1.y = (Y[4] & 127u) | ((Y[5] & 127u) << 8) | ((Y[6] & 127u) << 16) | ((Y[7] & 127u) << 24);
                w1.z = (Y[8] & 127u) | ((Y[9] & 127u) << 8) | ((Y[10] & 127u) << 16) | ((Y[11] & 127u) << 24);
                w1.w = (Y[12] & 127u) | ((Y[13] & 127u) << 8) | ((Y[14] & 127u) << 16) | ((Y[15] & 127u) << 24);
                *(uint4*)(smem + TK_SCR + tid * 32) = w0; *(uint4*)(smem + TK_SCR + tid * 32 + 16) = w1;
            }
            float f1[16], f2[16];
#pragma unroll
            for (int j = 0; j < 16; ++j) { f1[j] = tk_unord((X[j] & 0xFFFFFF80u) | 64u); f2[j] = tk_unord((Y[j] & 0xFFFFFF80u) | 64u); }
            unsigned ck[64];
            {
                int c = 0;
#pragma unroll
                for (int a = 0; a < 16; ++a)
#pragma unroll
                    for (int b = 0; b < 16; ++b) if (b < 16 / (a + 1)) { ck[c] = (tk_ord(f1[a] + f2[b]) & 0xFFFFFFC0u) | (unsigned)c; ++c; }
#pragma unroll
                for (int cc = 50; cc < 64; ++cc) ck[cc] = 0u;
            }
            tk_sort16(ck, 0); tk_sort16(ck, 16); tk_sort16(ck, 32); tk_sort16(ck, 48);
            tk_merge16(ck, 0, 16); tk_merge16(ck, 32, 48); tk_merge16(ck, 0, 32);
            wave_lds_fence();
            float val[16]; int eidx[16];
#pragma unroll
            for (int j = 0; j < 16; ++j) {
                const unsigned ab = smem[TK_TAB + (ck[j] & 63u)];
                const unsigned e1 = smem[TK_SCR + tid * 32 + (ab >> 4)], e2 = smem[TK_SCR + tid * 32 + 16 + (ab & 15u)];
                eidx[j] = (int)(e1 * 128u + e2);
                val[j] = tk_unord((ck[j] & 0xFFFFFFC0u) | 32u);
            }
            float sm = 0.f;
#pragma unroll
            for (int j = 15; j >= 0; --j) val[j] = __expf(val[j] - val[0]);
#pragma unroll
            for (int j = 0; j < 16; ++j) sm += val[j];
            const float inv = 1.0f / sm;
            if (hh == 0) {
                int* ip = IDX + (size_t)(t0 + r) * 128 + h * 16; float* gp = GATE + (size_t)(t0 + r) * 128 + h * 16;
#pragma unroll
                for (int q4 = 0; q4 < 4; ++q4) {
                    int4 iv; iv.x = eidx[q4 * 4 + 0]; iv.y = eidx[q4 * 4 + 1]; iv.z = eidx[q4 * 4 + 2]; iv.w = eidx[q4 * 4 + 3];
                    float4 gv; gv.x = val[q4 * 4 + 0] * inv; gv.y = val[q4 * 4 + 1] * inv; gv.z = val[q4 * 4 + 2] * inv; gv.w = val[q4 * 4 + 3] * inv;
                    *(int4*)(ip + q4 * 4) = iv; *(float4*)(gp + q4 * 4) = gv;
                }
            }
            wave_lds_fence();
        }
    }
}

#define G_RED_STEP(OFF, N) { const bool hi_ = (lane & OFF) != 0; _Pragma("unroll") for (int i_ = 0; i_ < N; ++i_) { const float send_ = hi_ ? part[i_] : part[i_ + N]; const float keep_ = hi_ ? part[i_ + N] : part[i_]; part[i_] = keep_ + __shfl_xor(send_, OFF); } }
typedef int i32x4g_t __attribute__((ext_vector_type(4)));
typedef int i32x8g_t __attribute__((ext_vector_type(8)));
#define LDSG(T, off) ((__attribute__((address_space(3))) T*)((__attribute__((address_space(3))) unsigned char*)smem + (off)))
constexpr int GA_ZERO = 7 * 2048 * 4;
constexpr int GA_XB = GA_ZERO + 2112;
typedef unsigned u32x2sw_t __attribute__((ext_vector_type(2)));
__device__ __forceinline__ float g_swap32_add(float x, float y) { const u32x2sw_t r = __builtin_amdgcn_permlane32_swap(__float_as_uint(x), __float_as_uint(y), false, false); const unsigned a0 = r.x, a1 = r.y; return __uint_as_float(a0) + __uint_as_float(a1); }
__device__ __forceinline__ float g_swap16_add(float x, float y) { const u32x2sw_t r = __builtin_amdgcn_permlane16_swap(__float_as_uint(x), __float_as_uint(y), false, false); const unsigned a0 = r.x, a1 = r.y; return __uint_as_float(a0) + __uint_as_float(a1); }
template <int CTRL> __device__ __forceinline__ float g_dpp(float s) { return __int_as_float(__builtin_amdgcn_update_dpp(0, __float_as_int(s), CTRL, 0xf, 0xf, true)); }
__device__ void st_gather(const Params& p, int bid, int nb, unsigned char* smem) {
    const int wv = __builtin_amdgcn_readfirstlane(threadIdx.x >> 6);
    float* gvl = (float*)smem;
    int tx = threadIdx.x; asm volatile("" : "+v"(tx));
    for (int i = tx; i < 2 * DM; i += NTHR) {
        const int b = i >> 11, k = i & (DM - 1);
        const float* mpb = (const float*)(p.ws + WS_M) + (size_t)b * 12288;
        gvl[b * (2 * DM) + k] = p.in[I_N2G][k] * (1.0f + mpb[4 * DM + k]);
        gvl[b * (2 * DM) + DM + k] = mpb[3 * DM + k];
        gvl[4 * DM + b * DM + k] = mpb[5 * DM + k];
        if (b == 0) gvl[6 * DM + k] = p.in[I_FNG][k];
    }
    for (int i = tx; i < 2112 / 4; i += NTHR) *LDSG(unsigned, GA_ZERO + i * 4) = 0u;
    __syncthreads();
    const bf16_t* H1b = (const bf16_t*)(p.ws + WS_H1);
    const float* SSQ = (const float*)(p.ws + WS_SSQ);
    const unsigned char* EU = p.ws + WS_EU;
    const unsigned char* EV = p.ws + WS_EV;
    const unsigned char* EU4 = p.ws + WS_EU4;
    const unsigned char* EV4 = p.ws + WS_EV4;
    const float* ESC = (const float*)(p.ws + WS_ESC);
    const int* IDX = (const int*)(p.ws + WS_IDX); const float* GATE = (const float*)(p.ws + WS_GATE);
    int ci0 = 0, ci1 = 0; float cg0 = 0.f, cg1 = 0.f, csq = 0.f, csu0 = 0.f, csu1 = 0.f, csv0 = 0.f, csv1 = 0.f; uint2 ch[8];
    {
        const int t0 = bid * 8 + wv;
        const int lane0 = tx & 63;
#pragma unroll
        for (int q = 0; q < 8; ++q) ch[q] = make_uint2(0u, 0u);
        if (t0 < TLAT) {
            ci0 = IDX[(size_t)t0 * 128 + lane0]; ci1 = IDX[(size_t)t0 * 128 + 64 + lane0]; cg0 = GATE[(size_t)t0 * 128 + lane0]; cg1 = GATE[(size_t)t0 * 128 + 64 + lane0];
            csq = lane0 < 32 ? SSQ[(size_t)t0 * 32 + lane0] : 0.f;
#pragma unroll
            for (int q = 0; q < 8; ++q) ch[q] = *(const uint2*)(H1b + (size_t)t0 * DM + q * 256 + lane0 * 4);
            const int scs0 = ((lane0 & 15) < PEER_NHI) ? 0 : 2 * 16384;
            csu0 = ESC[scs0 + ci0]; csu1 = ESC[scs0 + ci1]; csv0 = ESC[scs0 + 16384 + ci0]; csv1 = ESC[scs0 + 16384 + ci1];
        }
    }
    for (int t = bid * 8 + wv; t < TLAT; t += nb * 8) {
        int lane = (int)__builtin_amdgcn_mbcnt_hi(~0u, __builtin_amdgcn_mbcnt_lo(~0u, 0u)); asm volatile("" : "+v"(lane));
        const int tn = t + nb * 8; const bool has_next = tn < TLAT;
        float xn[32];
        {
            const float rstd = rsqrtf(wave_sum(csq) * (1.0f / DM) + EPS);
            const PG8_LAS float* gsl = (const PG8_LAS float*)gvl + (t >> 14) * (2 * DM) + lane * 4;
#pragma unroll
            for (int q = 0; q < 8; ++q) {
                const uint2 a = ch[q];
                const f32x4_t g0 = *(const PG8_LAS f32x4_t*)(gsl + q * 256), s0 = *(const PG8_LAS f32x4_t*)(gsl + DM + q * 256);
                xn[q * 4 + 0] = bflo(a.x) * rstd * g0[0] + s0[0]; xn[q * 4 + 1] = bfhi(a.x) * rstd * g0[1] + s0[1]; xn[q * 4 + 2] = bflo(a.y) * rstd * g0[2] + s0[2]; xn[q * 4 + 3] = bfhi(a.y) * rstd * g0[3] + s0[3];
            }
        }
        int ni0 = 0, ni1 = 0; float ng0 = 0.f, ng1 = 0.f, nsq = 0.f; uint2 nh[8];
#pragma unroll
        for (int q = 0; q < 8; ++q) nh[q] = make_uint2(0u, 0u);
        if (has_next) {
            ni0 = IDX[(size_t)tn * 128 + lane]; ni1 = IDX[(size_t)tn * 128 + 64 + lane]; ng0 = GATE[(size_t)tn * 128 + lane]; ng1 = GATE[(size_t)tn * 128 + 64 + lane];
            nsq = lane < 32 ? SSQ[(size_t)tn * 32 + lane] : 0.f;
#pragma unroll
            for (int q = 0; q < 8; ++q) nh[q] = *(const uint2*)(H1b + (size_t)tn * DM + q * 256 + lane * 4);
        }
        __builtin_amdgcn_sched_barrier(0);
        const unsigned lo16 = (unsigned)lane * 16u;
        f32x2v_t acc2[16];
#pragma unroll
        for (int j = 0; j < 16; ++j) acc2[j] = (f32x2v_t){0.f, 0.f};
        const int i0 = ci0, i1 = ci1;
        const int scsel = ((lane & 15) < PEER_NHI) ? 0 : 2 * 16384;
        const float su0 = csu0, su1 = csu1, gv0 = cg0 * csv0, gv1 = cg1 * csv1;
        const unsigned wbase = GA_XB + (unsigned)wv * 4096u;
        {
            unsigned hi[8], lo[8];
#pragma unroll
            for (int q = 0; q < 8; ++q) {
                int w = 0;
                w = __builtin_amdgcn_cvt_pk_fp8_f32(xn[4 * q + 0], xn[4 * q + 1], w, false);
                w = __builtin_amdgcn_cvt_pk_fp8_f32(xn[4 * q + 2], xn[4 * q + 3], w, true);
                hi[q] = (unsigned)w;
                const f32x2v_t d0 = __builtin_amdgcn_cvt_pk_f32_fp8(w, false), d1 = __builtin_amdgcn_cvt_pk_f32_fp8(w, true);
                int l = 0;
                l = __builtin_amdgcn_cvt_pk_fp8_f32(xn[4 * q + 0] - d0[0], xn[4 * q + 1] - d0[1], l, false);
                l = __builtin_amdgcn_cvt_pk_fp8_f32(xn[4 * q + 2] - d1[0], xn[4 * q + 3] - d1[1], l, true);
                lo[q] = (unsigned)l;
            }
            *LDSG(u32x4_t, wbase + lane * 32) = (u32x4_t){hi[0], hi[1], hi[2], hi[3]}; *LDSG(u32x4_t, wbase + lane * 32 + 16) = (u32x4_t){hi[4], hi[5], hi[6], hi[7]};
            *LDSG(u32x4_t, wbase + 2048 + lane * 32) = (u32x4_t){lo[0], lo[1], lo[2], lo[3]}; *LDSG(u32x4_t, wbase + 2048 + lane * 32 + 16) = (u32x4_t){lo[4], lo[5], lo[6], lo[7]};
        }
        const int mj = lane & 15, mg = lane >> 4;
        unsigned bsel = mj == 0 ? wbase + mg * 16 : (mj == 1 ? wbase + 2048 + mg * 16 : (unsigned)GA_ZERO); asm volatile("" : "+v"(bsel));
#define G_PIN16(X) asm volatile("" : "+v"(acc2[0]), "+v"(acc2[1]), "+v"(acc2[2]), "+v"(acc2[3]), "+v"(acc2[4]), "+v"(acc2[5]), "+v"(acc2[6]), "+v"(acc2[7]), \
                                  "+v"(acc2[8]), "+v"(acc2[9]), "+v"(acc2[10]), "+v"(acc2[11]), "+v"(acc2[12]), "+v"(acc2[13]), "+v"(acc2[14]), "+v"(acc2[15]), "+v"(X));
#define GU_LOAD(H) { \
            const int idl_ = __shfl((H) < 4 ? i0 : i1, (16 * (H) + mj) & 63); \
            const unsigned char* up_ = EU4 + (size_t)(unsigned)idl_ * (size_t)EROW4 + mg * 16; \
            _Pragma("unroll") for (int m = 0; m < 16; ++m) ufr[m] = *(const u32x4_t*)(up_ + m * 64); }
#define GV_LOAD(RV, K0) { \
            const int isrc = (K0) < 64 ? i0 : i1; \
            unsigned l16 = lo16; asm volatile("" : "+v"(l16)); \
            _Pragma("unroll") for (int ki = 0; ki < 4; ++ki) { const unsigned eo = (unsigned)__builtin_amdgcn_readlane(isrc, (((K0) + ki) & 63)) * (unsigned)EROW4; \
                RV[ki] = *(const u32x4_t*)(EV4 + eo + l16); } }
#define GV_COMP(RV, SB) { \
            _Pragma("unroll") for (int ki = 0; ki < 4; ++ki) { \
                const float wk = __builtin_bit_cast(float, __builtin_amdgcn_readlane(__builtin_bit_cast(int, wgt[ki]), 16 * (SB))); \
                const f32x2v_t wk2 = {wk, wk}; \
                _Pragma("unroll") for (int q = 0; q < 4; ++q) { const unsigned wq_ = RV[ki][q]; \
                    acc2[q * 4 + 0] = __builtin_amdgcn_cvt_scalef32_pk_f32_fp4(wq_, 1.0f, 0) * wk2 + acc2[q * 4 + 0]; acc2[q * 4 + 1] = __builtin_amdgcn_cvt_scalef32_pk_f32_fp4(wq_, 1.0f, 1) * wk2 + acc2[q * 4 + 1]; \
                    acc2[q * 4 + 2] = __builtin_amdgcn_cvt_scalef32_pk_f32_fp4(wq_, 1.0f, 2) * wk2 + acc2[q * 4 + 2]; acc2[q * 4 + 3] = __builtin_amdgcn_cvt_scalef32_pk_f32_fp4(wq_, 1.0f, 3) * wk2 + acc2[q * 4 + 3]; } \
                G_PIN16(RV[ki < 3 ? ki + 1 : 3]) } }
        {
            u32x4_t ufr[16], rvA[4], rvB[4];
            GU_LOAD(0)
            GV_LOAD(rvA, 0)
#pragma unroll 1
            for (int hd = 0; hd < 8; ++hd) {
                float sur[4], gvr[4];
#pragma unroll
                for (int r = 0; r < 4; ++r) { const int pl = (16 * hd + 4 * mg + r) & 63; sur[r] = __shfl(hd < 4 ? su0 : su1, pl); gvr[r] = __shfl(hd < 4 ? gv0 : gv1, pl); }
                f32x4_t d4 = {0.f, 0.f, 0.f, 0.f};
#pragma unroll
                for (int m = 0; m < 16; ++m) {
                    const u32x4_t b0 = *LDSG(u32x4_t, bsel + m * 128), b1 = *LDSG(u32x4_t, bsel + m * 128 + 64);
                    const i32x8g_t av = __builtin_shufflevector(__builtin_bit_cast(i32x4g_t, ufr[m]), __builtin_bit_cast(i32x4g_t, ufr[m]), 0, 1, 2, 3, -1, -1, -1, -1);
                    const i32x8g_t bv = __builtin_shufflevector(__builtin_bit_cast(i32x4g_t, b0), __builtin_bit_cast(i32x4g_t, b1), 0, 1, 2, 3, 4, 5, 6, 7);
                    d4 = __builtin_amdgcn_mfma_scale_f32_16x16x128_f8f6f4(av, bv, d4, 4, 0, 0, 0, 0, 0);
                }
                if (hd + 1 < 8) GU_LOAD(hd + 1)
                float wgt[4];
#pragma unroll
                for (int r = 0; r < 4; ++r) { const float dot = d4[r] + g_dpp<0xF5>(d4[r]); wgt[r] = gvr[r] * gelu_exact(dot * sur[r]); }
                GV_LOAD(rvB, 16 * hd + 4)
                GV_COMP(rvA, 0)
                GV_LOAD(rvA, 16 * hd + 8)
                GV_COMP(rvB, 1)
                GV_LOAD(rvB, 16 * hd + 12)
                GV_COMP(rvA, 2)
                if (hd + 1 < 8) GV_LOAD(rvA, 16 * hd + 16)
                GV_COMP(rvB, 3)
            }
        }
#undef GU_LOAD
#undef GV_LOAD
#undef GV_COMP
#undef G_PIN16
        float acc[32];
#pragma unroll
        for (int j = 0; j < 16; ++j) { acc[2 * j] = acc2[j][0]; acc[2 * j + 1] = acc2[j][1]; }
        float nsu0 = 0.f, nsu1 = 0.f, nsv0 = 0.f, nsv1 = 0.f;
        if (has_next) { nsu0 = ESC[scsel + ni0]; nsu1 = ESC[scsel + ni1]; nsv0 = ESC[scsel + 16384 + ni0]; nsv1 = ESC[scsel + 16384 + ni1]; }
        float ss2 = 0.f;
        {
            const PG8_LAS float* g2l = (const PG8_LAS float*)gvl + 4 * DM + (t >> 14) * DM + lane * 4;
#pragma unroll
            for (int q = 0; q < 8; ++q) {
                const uint2 hh = ch[q];
                const f32x4_t g20 = *(const PG8_LAS f32x4_t*)(g2l + q * 256);
                acc[q * 4 + 0] = bflo(hh.x) + g20[0] * acc[q * 4 + 0]; acc[q * 4 + 1] = bfhi(hh.x) + g20[1] * acc[q * 4 + 1];
                acc[q * 4 + 2] = bflo(hh.y) + g20[2] * acc[q * 4 + 2]; acc[q * 4 + 3] = bfhi(hh.y) + g20[3] * acc[q * 4 + 3];
            }
        }
#pragma unroll
        for (int j = 0; j < 32; ++j) ss2 += acc[j] * acc[j];
        ss2 = wave_sum(ss2);
        const float rs2 = rsqrtf(ss2 * (1.0f / DM) + EPS);
        {
            const PG8_LAS float* fgl = (const PG8_LAS float*)gvl + 6 * DM + lane * 4;
#pragma unroll
            for (int q = 0; q < 8; ++q) {
                const f32x4_t fg = *(const PG8_LAS f32x4_t*)(fgl + q * 256);
                float4 o;
                o.x = acc[q * 4 + 0] * rs2 * fg[0]; o.y = acc[q * 4 + 1] * rs2 * fg[1]; o.z = acc[q * 4 + 2] * rs2 * fg[2]; o.w = acc[q * 4 + 3] * rs2 * fg[3];
                *(float4*)(p.out + (size_t)t * DM + q * 256 + lane * 4) = o;
            }
        }
        ci0 = ni0; ci1 = ni1; cg0 = ng0; cg1 = ng1; csq = nsq; csu0 = nsu0; csu1 = nsu1; csv0 = nsv0; csv1 = nsv1;
#pragma unroll
        for (int q = 0; q < 8; ++q) ch[q] = nh[q];
    }
}

#define LAS __attribute__((address_space(3)))
#define XB_TMO      128
#define XB_XCNT(j)  (256  + 64 * (j))
#define XB_XSUB(j)  (1280 + 64 * (j))
#define XB_XGEN(j)  (2304 + 64 * (j))
#define XB_TOP      3328
#define XB_TOPGEN   3392
#define XCD_BAR_WORDS 3456
#define XB_SPIN_CAP (1u << 18)

__device__ __forceinline__ unsigned xb_ld(unsigned* p)              { return __hip_atomic_load(p, __ATOMIC_RELAXED, __HIP_MEMORY_SCOPE_AGENT); }
__device__ __forceinline__ unsigned xb_add(unsigned* p, unsigned v) { return __hip_atomic_fetch_add(p, v, __ATOMIC_RELAXED, __HIP_MEMORY_SCOPE_AGENT); }
__device__ __forceinline__ unsigned xb_xcc_id() { return (unsigned)__builtin_amdgcn_s_getreg((3 << 11) | 20) & 0xFu; }
#define XB_SPIN(cond, bar) do { unsigned _sp = 0; while (cond) { __builtin_amdgcn_s_sleep(1); \
    if ((++_sp & 255u) == 0u) { if (xb_ld(&(bar)[XB_TMO])) break; if (_sp > XB_SPIN_CAP) { atomicAdd(&(bar)[XB_TMO], 1u); break; } } } } while (0)

struct XcdBarrier {
    unsigned* bar; unsigned x;
    volatile LAS unsigned* st;
};

__device__ __forceinline__ XcdBarrier xcd_barrier_post(unsigned* bar, volatile LAS unsigned* st) {
    XcdBarrier b; b.bar = bar; b.x = xb_xcc_id(); b.st = st;
    if (threadIdx.x == 0) (void)xb_add(&bar[XB_XCNT(b.x)], 1u);
    return b;
}
__device__ __forceinline__ void xcd_barrier_complete(unsigned* bar, unsigned x, unsigned& nloc, unsigned& nx) {
    const unsigned G = gridDim.x * gridDim.y * gridDim.z;
    unsigned sum, cnt, mine, sp = 0u;
    for (;;) {
        sum = 0u; cnt = 0u; mine = 0u;
#pragma unroll
        for (unsigned j = 0; j < 16; ++j) { const unsigned c = xb_ld(&bar[XB_XCNT(j)]); sum += c; cnt += (c > 0u) ? 1u : 0u; mine = (j == x) ? c : mine; }
        if (sum == G) break;
        __builtin_amdgcn_s_sleep(1);
        if ((++sp & 255u) == 0u) { if (xb_ld(&bar[XB_TMO])) break; if (sp > XB_SPIN_CAP) { atomicAdd(&bar[XB_TMO], 1u); break; } }
    }
    nloc = mine > 0u ? mine : 1u; nx = cnt > 0u ? cnt : 1u;
}

__device__ __forceinline__ void xcd_barrier(const XcdBarrier& b) {
    asm volatile("s_waitcnt vmcnt(0)" ::: "memory");
    __syncthreads();
    if (threadIdx.x == 0) {
        unsigned* bar = b.bar;
        __builtin_amdgcn_s_waitcnt(0);
        unsigned nloc = b.st[0], nx = b.st[1];
        if (nloc == 0u) { xcd_barrier_complete(bar, b.x, nloc, nx); b.st[0] = nloc; b.st[1] = nx; }
        const unsigned old = xb_add(&bar[XB_XSUB(b.x)], 1u);
        const unsigned gen = old / nloc;
        if (old + 1u == (gen + 1u) * nloc) {
            __builtin_amdgcn_fence(__ATOMIC_RELEASE, "agent");
            asm volatile("s_waitcnt vmcnt(0)" ::: "memory");
            const unsigned og = xb_add(&bar[XB_TOP], 1u);
            const unsigned tg = og / nx;
            if (og + 1u == (tg + 1u) * nx) xb_add(&bar[XB_TOPGEN], 1u);
            else XB_SPIN(xb_ld(&bar[XB_TOPGEN]) == tg, bar);
            __builtin_amdgcn_fence(__ATOMIC_ACQUIRE, "agent");
            xb_add(&bar[XB_XGEN(b.x)], 1u);
            asm volatile("s_waitcnt vmcnt(0)" ::: "memory");
        } else {
            XB_SPIN(xb_ld(&bar[XB_XGEN(b.x)]) == gen, bar);
            __builtin_amdgcn_fence(__ATOMIC_ACQUIRE, "agent");
            asm volatile("s_waitcnt vmcnt(0)" ::: "memory");
        }
    }
    __syncthreads();
}


constexpr int LDS_BARST = LDS_BYTES - 16;

constexpr int N_STAGES = 12;
template <int S>
__device__ __forceinline__ void run_stage(const Params& p, unsigned char* smem) {
    const int bid = blockIdx.x, nb = gridDim.x;
    PG8_LAS unsigned char* lds3 = (PG8_LAS unsigned char*)smem;
    if constexpr (S == 0) { st_mod_direct(p, bid, nb, smem); st_skey_split(p, bid, nb); st_wprep(p, bid, nb, smem); st_econv(p, bid, nb); }
    if constexpr (S == 2) { st_wprep_q(p, bid, nb, smem); st_normmod(p, p.in[I_X], p.in[I_CTX], TALL, p.in[I_N1G], 0, DM, bid, nb); }
    if constexpr (S == 3) { pg8::Gemm g{(const bf16_t*)(p.ws + WS_A), (const bf16_t*)(p.ws + WS_BT1), TALL, NP, DM}; pg8::StaticOrder S_; S_.init(TALL, NP, nb, bid);
              EpiP E{(bf16_t*)(p.ws + WS_P), NP}; pg8::gemm_phase<EpiP, pg8::StaticOrder, GEMM_ALIGN_EPI, GEMM_SP2>(lds3, g, S_, E); }
    if constexpr (S == 4) { st_cq_final(p, bid); st_cmlp_mfma(p, bid, nb, smem); __syncthreads(); st_gla_passA(p, bid, nb, smem);
#if defined(PROBE_SUB) && PROBE_SUB == 1
        __syncthreads(); st_gla_passA(p, bid, nb, smem);
#elif defined(PROBE_SUB) && PROBE_SUB == 2
        __syncthreads(); st_cmlp_mfma(p, bid, nb, smem);
#endif
    }
    if constexpr (S == 5) {
#if defined(PROBE_SUB) && PROBE_SUB == 3
        st_gla_passB<true>(p, bid, nb); __syncthreads();
#endif
        st_gla_passB<false>(p, bid, nb); }
    if constexpr (S == 6) { st_gla_passC(p, bid, nb, smem); }
    if constexpr (S == 7) { pg8::Gemm g{(const bf16_t*)(p.ws + WS_A), (const bf16_t*)(p.ws + WS_BT2), TLAT, DM, DM}; pg8::StaticOrder S_; S_.init(TLAT, DM, nb, bid);
              EpiH1 E{(bf16_t*)(p.ws + WS_H1), p.in[I_X], (const float*)(p.ws + WS_M), (float*)(p.ws + WS_SSQ)}; pg8::gemm_phase<EpiH1, pg8::StaticOrder, GEMM_ALIGN_EPI, GEMM_SP2>(lds3, g, S_, E); }
    if constexpr (S == 9) { pg8::Gemm g{(const bf16_t*)(p.ws + WS_H1), (const bf16_t*)(p.ws + WS_BT3), TLAT, DM, DM}; pg8::StaticOrder S_; S_.init(TLAT, DM, nb, bid);
              EpiQ E{(bf16_t*)(p.ws + WS_Q), (const float*)(p.ws + WS_SSQ), (const float*)(p.ws + WS_CQ)}; pg8::gemm_phase<EpiQ, pg8::StaticOrder, GEMM_ALIGN_EPI, GEMM_SP2>(lds3, g, S_, E); }
    if constexpr (S == 10) { st_topk_mfma(p, bid, nb, smem); }
    if constexpr (S == 11) { st_gather(p, bid, nb, smem); }
}

template <int LO, int HI>
__global__ void __launch_bounds__(NTHR, 2) k_fwd(Params p) {
    extern __shared__ __attribute__((aligned(16))) unsigned char smem[];
#ifndef PROBE_DUP
#define PROBE_DUP (-1)
#endif
    constexpr bool MEGA = (HI - LO) > 1;
    XcdBarrier xbar; xbar.bar = nullptr; xbar.x = 0; xbar.st = nullptr;
    if constexpr (MEGA) {
        volatile LAS unsigned* st = (volatile LAS unsigned*)((LAS unsigned char*)smem + LDS_BARST);
        if (threadIdx.x < 2) st[threadIdx.x] = 0u;
        __syncthreads();
        xbar = xcd_barrier_post((unsigned*)(p.ws + WS_BAR), st);
    }
#define SEAM(k) { if constexpr (k == LO) cg::this_grid().sync(); else xcd_barrier(xbar); }
#define RUN_ST(k) if constexpr (LO <= k && k < HI && k != 8 && k != 1) { run_stage<k>(p, smem); if constexpr (k == PROBE_DUP) { SEAM(k) run_stage<k>(p, smem); } if constexpr (k + 1 < HI) SEAM(k) }
    RUN_ST(0) RUN_ST(1) RUN_ST(2) RUN_ST(3) RUN_ST(4) RUN_ST(5) RUN_ST(6) RUN_ST(7) RUN_ST(8) RUN_ST(9) RUN_ST(10) RUN_ST(11)
#undef RUN_ST
#undef SEAM
}

#ifndef N_LAUNCH_MODE
#define N_LAUNCH_MODE 0
#endif

template <int S> static void launch_stage(const Params& p, int grid, hipStream_t stream) {
    static bool attr_done = false;
    if (!attr_done) { hipFuncSetAttribute((const void*)k_fwd<S, S + 1>, hipFuncAttributeMaxDynamicSharedMemorySize, LDS_BYTES); attr_done = true; }
    hipLaunchKernelGGL((k_fwd<S, S + 1>), dim3(grid), dim3(NTHR), LDS_BYTES, stream, p);
}

extern "C" void kernel_launch(void* const* d_in, const int* in_sizes, int n_in, void* d_out, int out_size, void* d_ws, size_t ws_size, hipStream_t stream) {
    static int grid = 0;
    if (grid == 0) {
        if (n_in != N_IN || ws_size < WS_END) { fprintf(stderr, "kernel_launch: unexpected n_in %d / ws_size %zu (need %zu)\n", n_in, ws_size, (size_t)WS_END); grid = -1; return; }
        int dev = 0, cus = 0;
        hipGetDevice(&dev);
        hipDeviceGetAttribute(&cus, hipDeviceAttributeMultiprocessorCount, dev);
#if N_LAUNCH_MODE == 1
        int per_cu = 0;
        hipFuncSetAttribute((const void*)k_fwd<0, N_STAGES>, hipFuncAttributeMaxDynamicSharedMemorySize, LDS_BYTES);
        hipOccupancyMaxActiveBlocksPerMultiprocessor(&per_cu, (const void*)k_fwd<0, N_STAGES>, NTHR, LDS_BYTES);
        if (per_cu < 1) fprintf(stderr, "kernel_launch: occupancy query says %d blocks/CU\n", per_cu);
#endif
        grid = cus;
        (void)hipGetLastError();
    }
    if (grid < 0) return;
    Params p{};
    for (int i = 0; i < N_IN; ++i) p.in[i] = (const float*)d_in[i];
    p.out = (float*)d_out; p.ws = (unsigned char*)d_ws;
#if N_LAUNCH_MODE == 0
    launch_stage<0>(p, grid, stream); launch_stage<1>(p, grid, stream); launch_stage<2>(p, grid, stream); launch_stage<3>(p, grid, stream);
    launch_stage<4>(p, grid, stream); launch_stage<5>(p, grid, stream); launch_stage<6>(p, grid, stream); launch_stage<7>(p, grid, stream);
    launch_stage<8>(p, grid, stream); launch_stage<9>(p, grid, stream); launch_stage<10>(p, grid, stream); launch_stage<11>(p, grid, stream);
#else
    hipMemsetAsync((unsigned char*)d_ws + WS_BAR, 0, WS_BAR_BYTES, stream);
    void* args[] = {&p};
    hipError_t e = hipLaunchCooperativeKernel((const void*)k_fwd<0, N_STAGES>, dim3(grid), dim3(NTHR), args, LDS_BYTES, stream);
    if (e != hipSuccess) fprintf(stderr, "cooperative launch failed: %s (grid %d)\n", hipGetErrorString(e), grid);
#endif
}
```
